# Optimizing an MI355X kernel written in HIP

```python
import jax, jax.numpy as jnp
from jax import lax
import numpy as np

D_MODEL = 1024
BATCH = 4
SEQ = 4096
DEPTH = 1

CHUNK = 64
N_HEADS = 8
HEAD_DIM = 64
D_ATTN = N_HEADS * HEAD_DIM
LEFT_CHUNKS = 8
BAND = (LEFT_CHUNKS + 1) * CHUNK
REL_CLIP = 128
N_REL = 2 * REL_CLIP + 1
D_CONV = D_MODEL // 2
CONV_W = 31
N_BRANCH = 2
D_IN = 2 * D_CONV + 3 * D_ATTN + N_BRANCH * D_MODEL
PEER_HEADS = 8
PEER_NKEYS = 128
PEER_N = PEER_NKEYS * PEER_NKEYS
PEER_DQ = 256
PEER_DH = PEER_DQ // 2
PEER_TOPK = 16
PEER_BLOCK = 128
EPS = 1e-6
NEG_INF = -1e30

kernel_name = 'hybrid_conv_chunkattn_peer_adaln'


def rms_norm(x, g):
    xf = x.astype(jnp.float32)
    y = xf * lax.rsqrt(jnp.mean(xf * xf, axis=-1, keepdims=True) + EPS)
    return (y * g.astype(jnp.float32)).astype(x.dtype)


def layer_norm(x, g, b):
    xf = x.astype(jnp.float32)
    mu = jnp.mean(xf, axis=-1, keepdims=True)
    var = jnp.mean(jnp.square(xf - mu), axis=-1, keepdims=True)
    y = (xf - mu) * lax.rsqrt(var + EPS)
    return (y * g.astype(jnp.float32) + b.astype(jnp.float32)).astype(x.dtype)


def conv_module(a, b, conv_dw, conv_b, ln_g, ln_b, w_conv_out):
    u = a * jax.nn.sigmoid(b)
    y = lax.conv_general_dilated(
        u, conv_dw[:, None, :].astype(u.dtype), window_strides=(1,),
        padding=[(CONV_W - 1, 0)], dimension_numbers=('NWC', 'WIO', 'NWC'),
        feature_group_count=D_CONV) + conv_b
    y = jax.nn.silu(layer_norm(y, ln_g, ln_b))
    return y @ w_conv_out


def chunked_attention(q, k, v, q_norm_g, k_norm_g, rel_bias, w_attn_out):
    B, S, _ = q.shape
    nc = S // CHUNK
    q = rms_norm(q.reshape(B, S, N_HEADS, HEAD_DIM), q_norm_g)
    k = rms_norm(k.reshape(B, S, N_HEADS, HEAD_DIM), k_norm_g)
    v = v.reshape(B, S, N_HEADS, HEAD_DIM)
    qc = q.reshape(B, nc, CHUNK, N_HEADS, HEAD_DIM)
    pad = ((0, 0), (LEFT_CHUNKS * CHUNK, 0), (0, 0), (0, 0))
    kp = jnp.pad(k, pad).reshape(B, nc + LEFT_CHUNKS, CHUNK, N_HEADS, HEAD_DIM)
    vp = jnp.pad(v, pad).reshape(B, nc + LEFT_CHUNKS, CHUNK, N_HEADS, HEAD_DIM)
    band_idx = jnp.arange(nc)[:, None] + jnp.arange(LEFT_CHUNKS + 1)[None, :]
    kb = kp[:, band_idx].reshape(B, nc, BAND, N_HEADS, HEAD_DIM)
    vb = vp[:, band_idx].reshape(B, nc, BAND, N_HEADS, HEAD_DIM)
    s = jnp.einsum('bnqhd,bnkhd->bnhqk', qc, kb,
                   preferred_element_type=jnp.float32) * (HEAD_DIM ** -0.5)
    qpos = LEFT_CHUNKS * CHUNK + jnp.arange(CHUNK)
    kpos = jnp.arange(BAND)
    rel = jnp.clip(qpos[:, None] - kpos[None, :], -REL_CLIP, REL_CLIP) + REL_CLIP
    bias = rel_bias[:, rel].astype(jnp.float32)
    key_chunk = jnp.arange(nc)[:, None] - LEFT_CHUNKS + kpos[None, :] // CHUNK
    valid = key_chunk >= 0
    s = jnp.where(valid[None, :, None, None, :], s + bias[None, None], NEG_INF)
    p = jax.nn.softmax(s, axis=-1).astype(v.dtype)
    o = jnp.einsum('bnhqk,bnkhd->bnqhd', p, vb).reshape(B, S, D_ATTN)
    return o @ w_attn_out


def peer_ffn(h, peer_wq, peer_keys, peer_u, peer_v):
    B, S, D = h.shape
    T = B * S
    ht = h.reshape(T, D)
    q = (ht @ peer_wq).reshape(T, PEER_HEADS, 2, PEER_DH)
    s = jnp.einsum('thpd,hpkd->thpk', q, peer_keys,
                   preferred_element_type=jnp.float32)
    sv, si = lax.top_k(s, PEER_TOPK)
    cand = (sv[..., 0, :, None] + sv[..., 1, None, :]).reshape(T, PEER_HEADS, PEER_TOPK * PEER_TOPK)
    cidx = (si[..., 0, :, None] * PEER_NKEYS + si[..., 1, None, :]).reshape(T, PEER_HEADS, PEER_TOPK * PEER_TOPK)
    top, pos = lax.top_k(cand, PEER_TOPK)
    eidx = jnp.take_along_axis(cidx, pos, axis=-1)
    g = jax.nn.softmax(top, axis=-1).astype(h.dtype)
    nb = T // PEER_BLOCK

    def expert_block(args):
        hb, ib, gb = args
        u = peer_u[ib]
        a = jax.nn.gelu(jnp.einsum('td,thkd->thk', hb, u), approximate=False)
        return jnp.einsum('thk,thkd->td', gb * a, peer_v[ib])

    out = lax.map(expert_block, (ht.reshape(nb, PEER_BLOCK, D),
                                 eidx.reshape(nb, PEER_BLOCK, PEER_HEADS, PEER_TOPK),
                                 g.reshape(nb, PEER_BLOCK, PEER_HEADS, PEER_TOPK)))
    return out.reshape(B, S, D)


def setup_inputs(seed: int = 0) -> dict:
    key = jax.random.key(seed)
    ks = jax.random.split(key, 24)
    f32 = jnp.float32

    def nrm(k, shape, scale):
        return jax.random.normal(k, shape, f32) * scale

    L, D = DEPTH, D_MODEL
    return {
        'x': nrm(ks[0], (BATCH, SEQ, D), 1.0),
        'c': nrm(ks[1], (BATCH, D), 1.0),
        'w_ada': nrm(ks[2], (L, D, 6 * D), 0.5 * D ** -0.5),
        'b_ada': nrm(ks[3], (L, 6 * D), 0.02),
        'norm1_g': 1.0 + nrm(ks[4], (L, D), 0.1),
        'norm2_g': 1.0 + nrm(ks[5], (L, D), 0.1),
        'w_in': nrm(ks[6], (L, D, D_IN), D ** -0.5),
        'conv_dw': nrm(ks[7], (L, CONV_W, D_CONV), CONV_W ** -0.5),
        'conv_b': nrm(ks[8], (L, D_CONV), 0.02),
        'conv_ln_g': 1.0 + nrm(ks[9], (L, D_CONV), 0.1),
        'conv_ln_b': nrm(ks[10], (L, D_CONV), 0.02),
        'w_conv_out': nrm(ks[11], (L, D_CONV, D), D_CONV ** -0.5),
        'q_norm_g': 1.0 + nrm(ks[12], (L, HEAD_DIM), 0.1),
        'k_norm_g': 1.0 + nrm(ks[13], (L, HEAD_DIM), 0.1),
        'rel_bias': nrm(ks[14], (L, N_HEADS, N_REL), 0.5),
        'w_attn_out': nrm(ks[15], (L, D_ATTN, D), D_ATTN ** -0.5),
        'w_out': nrm(ks[16], (L, D, D), D ** -0.5),
        'peer_wq': nrm(ks[17], (L, D, PEER_HEADS * PEER_DQ), D ** -0.5),
        'peer_keys': nrm(ks[18], (L, PEER_HEADS, 2, PEER_NKEYS, PEER_DH), PEER_DH ** -0.5),
        'peer_u': nrm(ks[19], (L, PEER_N, D), D ** -0.5),
        'peer_v': nrm(ks[20], (L, PEER_N, D), PEER_HEADS ** -0.5),
    }


def reference(x, c, w_ada, b_ada, norm1_g, norm2_g, w_in, conv_dw, conv_b, conv_ln_g,
              conv_ln_b, w_conv_out, q_norm_g, k_norm_g, rel_bias, w_attn_out, w_out,
              peer_wq, peer_keys, peer_u, peer_v):
    split_pts = [D_CONV, 2 * D_CONV, 2 * D_CONV + D_ATTN,
                 2 * D_CONV + 2 * D_ATTN, 2 * D_CONV + 3 * D_ATTN, 2 * D_CONV + 3 * D_ATTN + D_MODEL]
    cond = jax.nn.silu(c)
    for l in range(DEPTH):
        mod = (cond @ w_ada[l] + b_ada[l])[:, None, :]
        sh1, sc1, ga1, sh2, sc2, ga2 = jnp.split(mod, 6, axis=-1)
        h = rms_norm(x, norm1_g[l]) * (1.0 + sc1) + sh1
        proj = h @ w_in[l]
        glu_a, glu_b, q, k, v, gl_conv, gl_attn = jnp.split(proj, split_pts, axis=-1)
        y_conv = conv_module(glu_a, glu_b, conv_dw[l], conv_b[l], conv_ln_g[l],
                             conv_ln_b[l], w_conv_out[l])
        y_attn = chunked_attention(q, k, v, q_norm_g[l], k_norm_g[l], rel_bias[l], w_attn_out[l])
        merged = jax.nn.sigmoid(gl_conv) * y_conv + jax.nn.sigmoid(gl_attn) * y_attn
        x = x + ga1 * (merged @ w_out[l])
        h2 = rms_norm(x, norm2_g[l]) * (1.0 + sc2) + sh2
        x = x + ga2 * peer_ffn(h2, peer_wq[l], peer_keys[l], peer_u[l], peer_v[l])
    return x
```

```cpp
#include <hip/hip_runtime.h>
#include <cstdio>
#include <cstdint>

typedef unsigned short bf16_t;
typedef short bf16x8 __attribute__((ext_vector_type(8)));
typedef float f32x4 __attribute__((ext_vector_type(4)));
#define LAS __attribute__((address_space(3)))

constexpr int D = 1024, BATCH = 4, SEQ = 4096, T = BATCH * SEQ;
constexpr int DIN = 4608, DC = 512, DA = 512, NH = 8, HD = 64, CHUNK = 64, NCH = SEQ / CHUNK;
constexpr int CONVW = 31, NREL = 257;
constexpr int PH = 8, NK = 128, DQ = 256, DHH = 128, TOPK = 16, NE = 128;
constexpr float EPS = 1e-6f;
#define NEG_BIG (-3.0e38f)
constexpr float U_SCALE = 96.f, V_SCALE = 5.5f;

constexpr size_t MiB = 1024 * 1024;
constexpr size_t OFF_BAR = 0, OFF_MOD = 16384, OFF_KEYB = 131072;
constexpr size_t OFF_WIN = 1 * MiB, OFF_WCO = 10 * MiB, OFF_WAO = 11 * MiB, OFF_WO = 12 * MiB, OFF_WQ = 14 * MiB;
constexpr size_t OFF_UB = 18 * MiB, OFF_VB = 34 * MiB, OFF_H = 82 * MiB;
constexpr size_t OFF_A = 114 * MiB, OFF_BG = 130 * MiB, OFF_Q = 146 * MiB, OFF_K = 162 * MiB, OFF_VT = 178 * MiB;
constexpr size_t OFF_MERGED = 114 * MiB, OFF_PQ = 114 * MiB;
constexpr size_t OFF_X1B = 48 * MiB;
constexpr size_t OFF_CACT = 194 * MiB, OFF_OATT = 210 * MiB, OFF_EIDX = 194 * MiB, OFF_GATE = 202 * MiB;
constexpr size_t OFF_LISTE = 114 * MiB, OFF_LISTG = 122 * MiB;
constexpr size_t OFF_ROWSS = 655360, OFF_PBIAS = 720896;
constexpr size_t WS_NEED = 226 * MiB;
constexpr int LDS_BYTES = 16 + 131072 + 512;

struct Params {
    const float *x, *c, *w_ada, *b_ada, *n1g, *n2g, *w_in, *conv_dw, *conv_b, *cln_g, *cln_b, *w_co, *qng, *kng, *relb, *w_ao, *w_o, *w_q, *keys, *pu, *pv;
    float* out;
    unsigned char* ws;
};

__device__ __forceinline__ bf16_t f2bf(float f) { unsigned u = __float_as_uint(f); u += 0x7fffu + ((u >> 16) & 1u); return (bf16_t)(u >> 16); }
__device__ __forceinline__ float bf2f(bf16_t h) { return __uint_as_float(((unsigned)h) << 16); }
__device__ __forceinline__ float sigmoidf_(float v) { return 1.f / (1.f + __expf(-v)); }


template <int CTRL> __device__ __forceinline__ float dpp_f(float v) { return __int_as_float(__builtin_amdgcn_update_dpp(0, __float_as_int(v), CTRL, 0xF, 0xF, false)); }
__device__ __forceinline__ float allmax16(float v) {
    v = fmaxf(v, dpp_f<0x121>(v)); v = fmaxf(v, dpp_f<0x122>(v)); v = fmaxf(v, dpp_f<0x124>(v)); v = fmaxf(v, dpp_f<0x128>(v)); return v;
}
__device__ __forceinline__ float allsum16(float v) {
    v += dpp_f<0x121>(v); v += dpp_f<0x122>(v); v += dpp_f<0x124>(v); v += dpp_f<0x128>(v); return v;
}
typedef unsigned u32x2_t __attribute__((ext_vector_type(2)));
__device__ __forceinline__ float xsum16(float v) { const u32x2_t r = __builtin_amdgcn_permlane16_swap(__float_as_uint(v), __float_as_uint(v), false, false); return __uint_as_float(r[0]) + __uint_as_float(r[1]); }
__device__ __forceinline__ float xsum32(float v) { const u32x2_t r = __builtin_amdgcn_permlane32_swap(__float_as_uint(v), __float_as_uint(v), false, false); return __uint_as_float(r[0]) + __uint_as_float(r[1]); }
__device__ __forceinline__ float xmax16(float v) { const u32x2_t r = __builtin_amdgcn_permlane16_swap(__float_as_uint(v), __float_as_uint(v), false, false); return fmaxf(__uint_as_float(r[0]), __uint_as_float(r[1])); }
__device__ __forceinline__ float xmax32(float v) { const u32x2_t r = __builtin_amdgcn_permlane32_swap(__float_as_uint(v), __float_as_uint(v), false, false); return fmaxf(__uint_as_float(r[0]), __uint_as_float(r[1])); }
__device__ __forceinline__ float wave_allsum(float v) { return xsum32(xsum16(allsum16(v))); }
__device__ __forceinline__ float dpp_xor4(float v) {
    const int x = __float_as_int(v);
    int r = __builtin_amdgcn_update_dpp(0, x, 0x104, 0xF, 0x5, false);
    r = __builtin_amdgcn_update_dpp(r, x, 0x114, 0xF, 0xA, false);
    return __int_as_float(r);
}
template <int CTRL> __device__ __forceinline__ int dpp_i(int v) { return __builtin_amdgcn_update_dpp(0, v, CTRL, 0xF, 0xF, false); }
__device__ __forceinline__ int dpp_xor4_i(int x) { int r = __builtin_amdgcn_update_dpp(0, x, 0x104, 0xF, 0x5, false); return __builtin_amdgcn_update_dpp(r, x, 0x114, 0xF, 0xA, false); }
__device__ __forceinline__ int xsum16_i(int v) { const u32x2_t r = __builtin_amdgcn_permlane16_swap((unsigned)v, (unsigned)v, false, false); return (int)(r[0] + r[1]); }
__device__ __forceinline__ int xsum32_i(int v) { const u32x2_t r = __builtin_amdgcn_permlane32_swap((unsigned)v, (unsigned)v, false, false); return (int)(r[0] + r[1]); }
__device__ __forceinline__ float packkey(float v, int idx, unsigned mask) { return __uint_as_float((__float_as_uint(v) & ~mask) | (unsigned)idx); }
#define CSWAP(a, b) do { const float _hi = fmaxf(a, b), _lo = fminf(a, b); a = _hi; b = _lo; } while (0)

#define XB_TMO      128
#define XB_XCNT(j)  (256  + 64 * (j))
#define XB_XSUB(j)  (1280 + 64 * (j))
#define XB_XGEN(j)  (2304 + 64 * (j))
#define XB_TOP      3328
#define XB_TOPGEN   3392
#define XCD_BAR_WORDS 3456
#define XB_SPIN_CAP (1u << 23)
__device__ __forceinline__ unsigned xb_ld(unsigned* p)              { return __hip_atomic_load(p, __ATOMIC_RELAXED, __HIP_MEMORY_SCOPE_AGENT); }
__device__ __forceinline__ unsigned xb_add(unsigned* p, unsigned v) { return __hip_atomic_fetch_add(p, v, __ATOMIC_RELAXED, __HIP_MEMORY_SCOPE_AGENT); }
__device__ __forceinline__ unsigned xb_xcc_id() { return (unsigned)__builtin_amdgcn_s_getreg((3 << 11) | 20) & 0xFu; }
#define XB_SPIN(cond, bar) do { unsigned _sp = 0; while (cond) { __builtin_amdgcn_s_sleep(1); \
    if ((++_sp & 255u) == 0u) { if (xb_ld(&(bar)[XB_TMO])) break; if (_sp > XB_SPIN_CAP) { atomicAdd(&(bar)[XB_TMO], 1u); break; } } } } while (0)
struct XcdBarrier { unsigned* bar; unsigned x; volatile LAS unsigned* st; };
__device__ __forceinline__ XcdBarrier xcd_barrier_post(unsigned* bar, volatile LAS unsigned* st) {
    XcdBarrier b; b.bar = bar; b.x = xb_xcc_id(); b.st = st;
    if (threadIdx.x == 0) (void)xb_add(&bar[XB_XCNT(b.x)], 1u);
    return b;
}
__device__ __forceinline__ void xcd_barrier_complete(unsigned* bar, unsigned x, unsigned& nloc, unsigned& nx) {
    const unsigned G = gridDim.x * gridDim.y * gridDim.z;
    unsigned sum, cnt, mine, sp = 0u;
    for (;;) {
        sum = 0u; cnt = 0u; mine = 0u;
#pragma unroll
        for (unsigned j = 0; j < 16; ++j) { const unsigned c = xb_ld(&bar[XB_XCNT(j)]); sum += c; cnt += (c > 0u) ? 1u : 0u; mine = (j == x) ? c : mine; }
        if (sum == G) break;
        __builtin_amdgcn_s_sleep(1);
        if ((++sp & 255u) == 0u) { if (xb_ld(&bar[XB_TMO])) break; if (sp > XB_SPIN_CAP) { atomicAdd(&bar[XB_TMO], 1u); break; } }
    }
    nloc = mine > 0u ? mine : 1u; nx = cnt > 0u ? cnt : 1u;
}
__device__ __forceinline__ void xcd_barrier(const XcdBarrier& b) {
    asm volatile("s_waitcnt vmcnt(0)" ::: "memory");
    __syncthreads();
    if (threadIdx.x == 0) {
        unsigned* bar = b.bar;
        __builtin_amdgcn_s_waitcnt(0);
        unsigned nloc = b.st[0], nx = b.st[1];
        if (nloc == 0u) { xcd_barrier_complete(bar, b.x, nloc, nx); b.st[0] = nloc; b.st[1] = nx; }
        const unsigned old = xb_add(&bar[XB_XSUB(b.x)], 1u);
        const unsigned gen = old / nloc;
        if (old + 1u == (gen + 1u) * nloc) {
            __builtin_amdgcn_fence(__ATOMIC_RELEASE, "agent");
            asm volatile("s_waitcnt vmcnt(0)" ::: "memory");
            const unsigned og = xb_add(&bar[XB_TOP], 1u);
            const unsigned tg = og / nx;
            if (og + 1u == (tg + 1u) * nx) xb_add(&bar[XB_TOPGEN], 1u);
            else XB_SPIN(xb_ld(&bar[XB_TOPGEN]) == tg, bar);
            __builtin_amdgcn_fence(__ATOMIC_ACQUIRE, "agent");
            xb_add(&bar[XB_XGEN(b.x)], 1u);
            asm volatile("s_waitcnt vmcnt(0)" ::: "memory");
        } else {
            XB_SPIN(xb_ld(&bar[XB_XGEN(b.x)]) == gen, bar);
            __builtin_amdgcn_fence(__ATOMIC_ACQUIRE, "agent");
            asm volatile("s_waitcnt vmcnt(0)" ::: "memory");
        }
    }
    __syncthreads();
}

__host__ __device__ __forceinline__ int winperm(int col) {
    if (col < 1024) { const int c = col & 511, isb = col >> 9; return 256 * (c >> 7) + 128 * isb + (c & 127); }
    if (col < 2048) { const int cc = col - 1024, t = cc >> 8, hh = (cc >> 6) & 3, dd = cc & 63; return 1024 + 256 * t + 128 * (dd >> 5) + 32 * hh + (dd & 31); }
    return col;
}

__device__ __forceinline__ void tr_unit(const Params& p, float* smf, int t, int tid) {
    const float* src; bf16_t* dst; int K, N;
    if (t < 288)      { src = p.w_in; dst = (bf16_t*)(p.ws + OFF_WIN); K = 1024; N = 4608; }
    else if (t < 320) { t -= 288; src = p.w_co; dst = (bf16_t*)(p.ws + OFF_WCO); K = 512; N = 1024; }
    else if (t < 352) { t -= 320; src = p.w_ao; dst = (bf16_t*)(p.ws + OFF_WAO); K = 512; N = 1024; }
    else if (t < 416) { t -= 352; src = p.w_o; dst = (bf16_t*)(p.ws + OFF_WO); K = 1024; N = 1024; }
    else              { t -= 416; src = p.w_q; dst = (bf16_t*)(p.ws + OFF_WQ); K = 1024; N = 2048; }
    const int tiles_n = N / 256, kt = t / tiles_n, nt = t % tiles_n;
    float* tl = smf;
    float4 tv[8];
#pragma unroll
    for (int i = 0; i < 8; ++i) { const int idx = tid + 512 * i, r = idx >> 6, c4 = (idx & 63) * 4; tv[i] = *(const float4*)&src[(size_t)(kt * 64 + r) * N + nt * 256 + c4]; }
#pragma unroll
    for (int i = 0; i < 8; ++i) {
        const int idx = tid + 512 * i, r = idx >> 6, c4 = (idx & 63) * 4;
        tl[(c4 + 0) * 65 + r] = tv[i].x; tl[(c4 + 1) * 65 + r] = tv[i].y; tl[(c4 + 2) * 65 + r] = tv[i].z; tl[(c4 + 3) * 65 + r] = tv[i].w;
    }
    __syncthreads();
#pragma unroll
    for (int i = 0; i < 4; ++i) {
        const int idx = tid + 512 * i, n = idx >> 3, k8 = (idx & 7) * 8;
        bf16x8 o;
#pragma unroll
        for (int j = 0; j < 8; ++j) o[j] = (short)f2bf(tl[n * 65 + k8 + j]);
        int drow = nt * 256 + n;
        if (src == p.w_in) drow = winperm(drow);
        *(bf16x8*)&dst[(size_t)drow * K + kt * 64 + k8] = o;
    }
    __syncthreads();
}
__device__ __forceinline__ void keys_unit(const Params& p, int e, int tid) {
#pragma unroll
    for (int i = 0; i < 4; ++i) {
        const size_t idx4 = (size_t)e * 2048 + i * 512 + tid;
        const float4 v = ((const float4*)p.keys)[idx4];
        ushort4 o; o.x = f2bf(v.x); o.y = f2bf(v.y); o.z = f2bf(v.z); o.w = f2bf(v.w);
        ((ushort4*)(p.ws + OFF_KEYB))[idx4] = o;
    }
}
__device__ __forceinline__ void st_prologue(const Params& p, float* smf) {
    int tid_ = threadIdx.x; asm volatile("" : "+v"(tid_)); const int tid = tid_;
    constexpr int NU_MOD = 192, NU_TR = 288;
    float* mod = (float*)(p.ws + OFF_MOD);
    for (int u = blockIdx.x; u < NU_MOD + NU_TR; u += gridDim.x) {
        if (u < NU_MOD) {
            float* sc = smf;
            float* red = smf + 4096;
            for (int i = tid; i < 4096; i += 512) { const float v = p.c[i]; sc[i] = v / (1.f + expf(-v)); }
            __syncthreads();
            const int cl = tid & 31, ks = tid >> 5, col = u * 32 + cl;
            float a0 = 0.f, a1 = 0.f, a2 = 0.f, a3 = 0.f;
#pragma unroll
            for (int kk = 0; kk < 64; ++kk) {
                const int k = ks * 64 + kk;
                const float w = p.w_ada[(size_t)k * 6144 + col];
                a0 += sc[k] * w; a1 += sc[1024 + k] * w; a2 += sc[2048 + k] * w; a3 += sc[3072 + k] * w;
            }
            red[(ks * 32 + cl) * 4 + 0] = a0; red[(ks * 32 + cl) * 4 + 1] = a1; red[(ks * 32 + cl) * 4 + 2] = a2; red[(ks * 32 + cl) * 4 + 3] = a3;
            __syncthreads();
            if (tid < 128) {
                const int c2 = tid & 31, b = tid >> 5;
                float s = p.b_ada[u * 32 + c2];
                for (int k2 = 0; k2 < 16; ++k2) s += red[(k2 * 32 + c2) * 4 + b];
                mod[b * 6144 + u * 32 + c2] = s;
            }
            __syncthreads();
        } else tr_unit(p, smf, u - NU_MOD, tid);
    }
}
__device__ __forceinline__ void st_prologue2(const Params& p, float* smf, int part, int nparts) {
    int tid_ = threadIdx.x; asm volatile("" : "+v"(tid_)); const int tid = tid_;
    if (part < 0) return;
    for (int v = part; v < 288; v += nparts) {
        if (v < 256) tr_unit(p, smf, 288 + v, tid); else keys_unit(p, v - 256, tid);
    }
}

__device__ __forceinline__ void st_rownorm(const Params& p, const float* xin, const float* g, int off_sh, int off_sc, bf16_t* hout) {
    int tid_ = threadIdx.x; asm volatile("" : "+v"(tid_)); const int tid = tid_, lane = tid & 63, wave = tid >> 6;
    const float* mod = (const float*)(p.ws + OFF_MOD);
    constexpr int RPW = 4;
    for (int u = blockIdx.x; u < T / (8 * RPW); u += gridDim.x) {
        const int t0 = (u * 8 + wave) * RPW, b = t0 >> 12;
        float4 v[RPW][4];
#pragma unroll
        for (int r = 0; r < RPW; ++r)
#pragma unroll
            for (int i = 0; i < 4; ++i) v[r][i] = ((const float4*)(xin + (size_t)(t0 + r) * D))[lane + 64 * i];
        float4 gm[4], sh[4];
#pragma unroll
        for (int i = 0; i < 4; ++i) {
            const float4 g4 = ((const float4*)g)[lane + 64 * i];
            const float4 sc = ((const float4*)(mod + b * 6144 + off_sc))[lane + 64 * i];
            sh[i] = ((const float4*)(mod + b * 6144 + off_sh))[lane + 64 * i];
            gm[i] = make_float4(g4.x * (1.f + sc.x), g4.y * (1.f + sc.y), g4.z * (1.f + sc.z), g4.w * (1.f + sc.w));
        }
#pragma unroll
        for (int r = 0; r < RPW; ++r) {
            float ss = 0.f;
#pragma unroll
            for (int i = 0; i < 4; ++i) ss += v[r][i].x * v[r][i].x + v[r][i].y * v[r][i].y + v[r][i].z * v[r][i].z + v[r][i].w * v[r][i].w;
            ss = wave_allsum(ss);
            const float rstd = rsqrtf(ss * (1.f / D) + EPS);
#pragma unroll
            for (int i = 0; i < 4; ++i) {
                ushort4 o;
                o.x = f2bf(v[r][i].x * rstd * gm[i].x + sh[i].x);
                o.y = f2bf(v[r][i].y * rstd * gm[i].y + sh[i].y);
                o.z = f2bf(v[r][i].z * rstd * gm[i].z + sh[i].z);
                o.w = f2bf(v[r][i].w * rstd * gm[i].w + sh[i].w);
                ((ushort4*)(hout + (size_t)(t0 + r) * D))[lane + 64 * i] = o;
            }
        }
    }
}

__device__ __forceinline__ void st_prep2(const Params& p) {
    float* rowss = (float*)(p.ws + OFF_ROWSS);
    for (int i = blockIdx.x * 512 + threadIdx.x; i < T; i += gridDim.x * 512) rowss[i] = 0.f;
}
__device__ __forceinline__ void st_pbias(const Params& p) {
    int tid_ = threadIdx.x; asm volatile("" : "+v"(tid_)); const int tid = tid_, lane = tid & 63, wave = tid >> 6;
    const float* mod = (const float*)(p.ws + OFF_MOD);
    float* pbias = (float*)(p.ws + OFF_PBIAS);
    const bf16_t* WQ = (const bf16_t*)(p.ws + OFF_WQ);
    for (int n = blockIdx.x * 8 + wave; n < 2048; n += gridDim.x * 8) {
        const bf16x8 w0 = *(const bf16x8*)(WQ + (size_t)n * D + 16 * lane), w1 = *(const bf16x8*)(WQ + (size_t)n * D + 16 * lane + 8);
        float wf[16];
#pragma unroll
        for (int k = 0; k < 8; ++k) { wf[k] = bf2f((bf16_t)w0[k]); wf[8 + k] = bf2f((bf16_t)w1[k]); }
#pragma unroll
        for (int b = 0; b < 4; ++b) {
            const float* shp = mod + b * 6144 + 3072 + 16 * lane;
            float a = 0.f;
#pragma unroll
            for (int k4 = 0; k4 < 4; ++k4) { const float4 q4 = *(const float4*)(shp + 4 * k4); a += q4.x * wf[4 * k4] + q4.y * wf[4 * k4 + 1] + q4.z * wf[4 * k4 + 2] + q4.w * wf[4 * k4 + 3]; }
            a = wave_allsum(a);
            if (lane == 0) pbias[b * 2048 + n] = a;
        }
    }
}

namespace pg8 {
#define PG8_LAS __attribute__((address_space(3)))
typedef unsigned u32x4 __attribute__((ext_vector_type(4)));
constexpr int BM = 256, BK = 64, HALF = 128, HTB = HALF * BK * 2, STAGE_BYTES = 8 * HTB, NXCD = 8, WGM = 8;
__host__ __device__ __forceinline__ int lds_byte(int r, int c) { const int st = (r >> 4) * 2 + (c >> 5), rr = r & 15, cc = c & 31, ob = rr * 64 + cc * 2; return st * 1024 + (ob ^ (((ob >> 9) & 1) << 5)); }
__host__ __device__ __forceinline__ void stage_rc(int b, int& R, int& C) { const int st = b / 1024, sb = b % 1024, swz = sb ^ (((sb >> 9) & 1) << 5); R = (st >> 1) * 16 + swz / 64; C = (st & 1) * 32 + (swz % 64) / 2; }
__host__ __device__ __forceinline__ int perm32(int rho) { const int n = rho >> 4, i = rho & 15; return 8 * (i >> 2) + 4 * n + (i & 3); }
struct Unit { int pm, pn; };
struct Gemm { const bf16_t* A; const bf16_t* Bt; int M, N, K; };
struct StaticOrder {
    int nM, nN, nwg, G, c;
    __host__ __device__ void init(int M, int N, int G_, int c_) { nM = M / BM; nN = N / BM; nwg = nM * nN; G = G_; c = c_; }
    __host__ __device__ bool next(int i, Unit& u) const {
        const long L = (long)i * G + c; if (L >= nwg) return false;
        int wgid = (int)L; { const int q = nwg / NXCD, r = nwg % NXCD, xcd = wgid % NXCD, off = wgid / NXCD; wgid = (xcd < r ? xcd * (q + 1) : r * (q + 1) + (xcd - r) * q) + off; }
        const int nig = WGM * nN, gid = wgid / nig, fm = gid * WGM, gsz = (nM - fm) < WGM ? (nM - fm) : WGM;
        u.pm = fm + ((wgid % nig) % gsz); u.pn = (wgid % nig) / gsz; return true;
    }
    __device__ __forceinline__ void a_ready(const Unit&) const {}
    __device__ __forceinline__ void done(const Unit&) const {}
};
__device__ __forceinline__ unsigned cvt_pk_bf16(float lo, float hi) { unsigned r; asm volatile("v_cvt_pk_bf16_f32 %0, %1, %2" : "=v"(r) : "v"(lo), "v"(hi)); return r; }

template <class Epi, class Sched>
__device__ __forceinline__ void gemm_phase(PG8_LAS unsigned char* lds, const Gemm g, const Sched& S, const Epi& E) {
    int tid = threadIdx.x; asm volatile("" : "+v"(tid));
    const int wid = __builtin_amdgcn_readfirstlane(tid >> 6), lane = tid & 63, wr = wid >> 2, wc = wid & 3, fr = lane & 15, fq = lane >> 4;
    const int K = g.K, nt = K / BK;
    unsigned voffA[2], voffB[2];
#pragma unroll
    for (int i = 0; i < 2; ++i) { int R, C; stage_rc(tid * 16 + i * 8192, R, C); const int Rb = Epi::PERM ? ((R & ~31) + perm32(R & 31)) : R;
        voffA[i] = (unsigned)(R * K + C) * 2u; voffB[i] = (unsigned)(Rb * K + C) * 2u; }
    const size_t kstep = (size_t)(BK * 2);
    const size_t hstep = (size_t)HALF * K * 2;
    const size_t tstep = 2 * hstep;
    const unsigned ldsw = (unsigned)wid * 1024u;
    const int aoff = lds_byte(wr * 64 + fr, fq * 8), boff = lds_byte(wc * 32 + fr, fq * 8);
#define PG8_SA(b, h) (((b) * 2 + (h)) * HTB)
#define PG8_SB(b, h) ((4 + (b) * 2 + (h)) * HTB)
#define PG8_STAGE(bufoff, gbase, voff) do { _Pragma("unroll") for (int _i = 0; _i < 2; ++_i) \
        __builtin_amdgcn_global_load_lds((const unsigned*)((const char*)(gbase) + (voff)[_i]), (PG8_LAS unsigned*)(lds + (bufoff) + ldsw + _i * 8192), 16, 0, 0); } while (0)
#define PG8_LDA(dst, b, h) do { _Pragma("unroll") for (int m = 0; m < 4; ++m) _Pragma("unroll") for (int k = 0; k < 2; ++k) dst[m][k] = *(const PG8_LAS bf16x8*)(lds + PG8_SA(b, h) + aoff + m * 2048 + k * 1024); } while (0)
#define PG8_LDB(dst, b, h) do { _Pragma("unroll") for (int n = 0; n < 2; ++n) _Pragma("unroll") for (int k = 0; k < 2; ++k) dst[n][k] = *(const PG8_LAS bf16x8*)(lds + PG8_SB(b, h) + boff + n * 2048 + k * 1024); } while (0)
#define PG8_MMA(ai, bj, At, Bt) do { __builtin_amdgcn_s_setprio(1); _Pragma("unroll") for (int m = 0; m < 4; ++m) _Pragma("unroll") for (int n = 0; n < 2; ++n) _Pragma("unroll") for (int k = 0; k < 2; ++k) \
        acc[ai][bj][m][n] = __builtin_amdgcn_mfma_f32_16x16x32_bf16(Bt[n][k], At[m][k], acc[ai][bj][m][n], 0, 0, 0); __builtin_amdgcn_s_setprio(0); } while (0)
#define PG8_WAIT_V(n) asm volatile("s_waitcnt vmcnt(" #n ")" ::: "memory")
#define PG8_WAIT_L(n) asm volatile("s_waitcnt lgkmcnt(" #n ")" ::: "memory")
#define PG8_BAR __builtin_amdgcn_s_barrier()
#define PG8_SCHED __builtin_amdgcn_sched_barrier(0)
    Unit cur, nxt; int ui = 0;
    if (!S.next(0, cur)) return;
    f32x4 acc[2][2][4][2];
#pragma unroll
    for (int a = 0; a < 2; ++a)
#pragma unroll
        for (int b = 0; b < 2; ++b)
#pragma unroll
            for (int m = 0; m < 4; ++m)
#pragma unroll
                for (int n = 0; n < 2; ++n) acc[a][b][m][n] = (f32x4){0.f, 0.f, 0.f, 0.f};
    bf16x8 At[4][2], B0[2][2], B1[2][2];
    const char* cA = (const char*)g.A + (size_t)cur.pm * tstep; const char* cB = (const char*)g.Bt + (size_t)cur.pn * tstep;
    S.a_ready(cur);
    PG8_STAGE(PG8_SB(0, 0), cB, voffB); PG8_STAGE(PG8_SA(0, 0), cA, voffA); PG8_STAGE(PG8_SB(0, 1), cB + hstep, voffB); PG8_STAGE(PG8_SA(0, 1), cA + hstep, voffA);
    if (wr == 1) PG8_BAR;
    PG8_WAIT_V(4); PG8_BAR;
    PG8_STAGE(PG8_SB(1, 0), cB + kstep, voffB); PG8_STAGE(PG8_SA(1, 0), cA + kstep, voffA); PG8_STAGE(PG8_SB(1, 1), cB + hstep + kstep, voffB);
    PG8_WAIT_V(6); PG8_BAR;
    for (;;) {
        const bool has_next = S.next(ui + 1, nxt);
        const char* nA = has_next ? (const char*)g.A + (size_t)nxt.pm * tstep : cA; const char* nB = has_next ? (const char*)g.Bt + (size_t)nxt.pn * tstep : cB;
        for (int t = 0; t < nt; t += 2) {
            const bool last = (t == nt - 2);
            const char* a1 = cA + (size_t)(t + 1) * kstep;
            const char* a2 = last ? nA : cA + (size_t)(t + 2) * kstep; const char* b2 = last ? nB : cB + (size_t)(t + 2) * kstep;
            const char* a3 = a2 + kstep; const char* b3 = b2 + kstep;
            if (last && has_next) S.a_ready(nxt);
            PG8_LDB(B0, 0, 0); PG8_SCHED; PG8_LDA(At, 0, 0); PG8_STAGE(PG8_SA(1, 1), a1 + hstep, voffA);
            PG8_WAIT_L(8); PG8_BAR; PG8_WAIT_L(0); PG8_MMA(0, 0, At, B0); PG8_BAR; PG8_SCHED;
            PG8_LDB(B1, 0, 1); PG8_STAGE(PG8_SB(0, 0), b2, voffB);
            PG8_BAR; PG8_WAIT_L(0); PG8_MMA(0, 1, At, B1); PG8_BAR;
            PG8_LDA(At, 0, 1); PG8_STAGE(PG8_SA(0, 0), a2, voffA);
            PG8_BAR; PG8_WAIT_L(0); PG8_MMA(1, 0, At, B0); PG8_BAR; PG8_SCHED;
            PG8_STAGE(PG8_SB(0, 1), b2 + hstep, voffB);
            PG8_WAIT_V(6); PG8_BAR; PG8_MMA(1, 1, At, B1); PG8_BAR;
            PG8_LDB(B0, 1, 0); PG8_SCHED; PG8_LDA(At, 1, 0); PG8_STAGE(PG8_SA(0, 1), a2 + hstep, voffA);
            PG8_WAIT_L(8); PG8_BAR; PG8_WAIT_L(0); PG8_MMA(0, 0, At, B0); PG8_BAR; PG8_SCHED;
            PG8_LDB(B1, 1, 1); PG8_STAGE(PG8_SB(1, 0), b3, voffB);
            PG8_BAR; PG8_WAIT_L(0); PG8_MMA(0, 1, At, B1); PG8_BAR;
            PG8_LDA(At, 1, 1); PG8_STAGE(PG8_SA(1, 0), a3, voffA);
            PG8_BAR; PG8_WAIT_L(0); PG8_MMA(1, 0, At, B0); PG8_BAR; PG8_SCHED;
            PG8_STAGE(PG8_SB(1, 1), b3 + hstep, voffB);
            PG8_WAIT_V(6); PG8_BAR; PG8_MMA(1, 1, At, B1); PG8_BAR;
        }
        E(acc, cur, wr, wc, fr, fq); S.done(cur);
        if (!has_next) break;
#pragma unroll
        for (int a = 0; a < 2; ++a)
#pragma unroll
            for (int b = 0; b < 2; ++b)
#pragma unroll
                for (int m = 0; m < 4; ++m)
#pragma unroll
                    for (int n = 0; n < 2; ++n) acc[a][b][m][n] = (f32x4){0.f, 0.f, 0.f, 0.f};
        cur = nxt; cA = nA; cB = nB; ++ui;
    }
    PG8_WAIT_V(0);
    if (wr == 0) PG8_BAR;
    PG8_BAR;
#undef PG8_SA
#undef PG8_SB
#undef PG8_STAGE
#undef PG8_LDA
#undef PG8_LDB
#undef PG8_MMA
#undef PG8_WAIT_V
#undef PG8_WAIT_L
#undef PG8_BAR
#undef PG8_SCHED
}

struct EpiInproj {
    static constexpr bool PERM = true;
    bf16_t *U, *Q, *Kb, *VT, *GC; const float *qng, *kng;
    __device__ __forceinline__ void operator()(const f32x4 (&acc)[2][2][4][2], const Unit& u, int wr, int wc, int fr, int fq) const {
        const int row0 = u.pm * BM + wr * 64 + fr, colt = u.pn * BM + wc * 32 + 8 * fq, seg = u.pn;
        if (seg < 4) {
#pragma unroll
            for (int ai = 0; ai < 2; ++ai)
#pragma unroll
                for (int m = 0; m < 4; ++m) {
                    const int row = row0 + ai * HALF + m * 16;
                    float r[8];
#pragma unroll
                    for (int j = 0; j < 4; ++j) { r[j] = acc[ai][0][m][0][j] * sigmoidf_(acc[ai][1][m][0][j]); r[4 + j] = acc[ai][0][m][1][j] * sigmoidf_(acc[ai][1][m][1][j]); }
                    u32x4 w; w.x = cvt_pk_bf16(r[0], r[1]); w.y = cvt_pk_bf16(r[2], r[3]); w.z = cvt_pk_bf16(r[4], r[5]); w.w = cvt_pk_bf16(r[6], r[7]);
                    *(u32x4*)(U + (size_t)row * 512 + 128 * seg + wc * 32 + 8 * fq) = w;
                }
        } else if (seg < 8) {
            const int t = seg - 4, isk = t >> 1, head = (t & 1) * 4 + wc;
            bf16_t* base = isk ? Kb : Q;
            const float* gp = (isk ? kng : qng) + 8 * fq;
            const f32x4 g0 = *(const f32x4*)gp, g1 = *(const f32x4*)(gp + 4), g2 = *(const f32x4*)(gp + 32), g3 = *(const f32x4*)(gp + 36);
            const float qs = isk ? 1.f : 0.18033688011112042f;
#pragma unroll
            for (int ai = 0; ai < 2; ++ai)
#pragma unroll
                for (int m = 0; m < 4; ++m) {
                    const int row = row0 + ai * HALF + m * 16;
                    const f32x4 a0 = acc[ai][0][m][0], a1 = acc[ai][0][m][1], b0 = acc[ai][1][m][0], b1 = acc[ai][1][m][1];
                    float ss = 0.f;
#pragma unroll
                    for (int j = 0; j < 4; ++j) ss += a0[j] * a0[j] + a1[j] * a1[j] + b0[j] * b0[j] + b1[j] * b1[j];
                    ss = xsum32(xsum16(ss));
                    const float rstd = rsqrtf(ss * (1.f / 64.f) + EPS) * qs;
                    const f32x4 y0 = a0 * g0 * rstd, y1 = a1 * g1 * rstd, y2 = b0 * g2 * rstd, y3 = b1 * g3 * rstd;
                    u32x4 w; w.x = cvt_pk_bf16(y0[0], y0[1]); w.y = cvt_pk_bf16(y0[2], y0[3]); w.z = cvt_pk_bf16(y1[0], y1[1]); w.w = cvt_pk_bf16(y1[2], y1[3]);
                    *(u32x4*)(base + (size_t)row * 512 + head * 64 + 8 * fq) = w;
                    w.x = cvt_pk_bf16(y2[0], y2[1]); w.y = cvt_pk_bf16(y2[2], y2[3]); w.z = cvt_pk_bf16(y3[0], y3[1]); w.w = cvt_pk_bf16(y3[2], y3[3]);
                    *(u32x4*)(base + (size_t)row * 512 + head * 64 + 32 + 8 * fq) = w;
                }
        } else {
#pragma unroll
            for (int ai = 0; ai < 2; ++ai)
#pragma unroll
                for (int m = 0; m < 4; ++m) {
                    const int row = row0 + ai * HALF + m * 16;
#pragma unroll
                    for (int bj = 0; bj < 2; ++bj) {
                        const int col = colt + bj * HALF;
                        f32x4 v0 = acc[ai][bj][m][0], v1 = acc[ai][bj][m][1];
                        if (seg < 10) {
                            u32x4 w; w.x = cvt_pk_bf16(v0[0], v0[1]); w.y = cvt_pk_bf16(v0[2], v0[3]); w.z = cvt_pk_bf16(v1[0], v1[1]); w.w = cvt_pk_bf16(v1[2], v1[3]);
                            *(u32x4*)(VT + (size_t)row * 512 + (col - 2048)) = w;
                        } else {
                            bf16_t* base = GC + (seg >= 14 ? (size_t)T * D : (size_t)0);
#pragma unroll
                            for (int j = 0; j < 4; ++j) { v0[j] = sigmoidf_(v0[j]); v1[j] = sigmoidf_(v1[j]); }
                            u32x4 w; w.x = cvt_pk_bf16(v0[0], v0[1]); w.y = cvt_pk_bf16(v0[2], v0[3]); w.z = cvt_pk_bf16(v1[0], v1[1]); w.w = cvt_pk_bf16(v1[2], v1[3]);
                            *(u32x4*)(base + (size_t)row * 1024 + ((col - 2560) & 1023)) = w;
                        }
                    }
                }
        }
    }
};
template <int PASS> struct EpiMerge {
    static constexpr bool PERM = true;
    bf16_t* MG; const bf16_t* G;
    __device__ __forceinline__ void operator()(const f32x4 (&acc)[2][2][4][2], const Unit& u, int wr, int wc, int fr, int fq) const {
        const int row0 = u.pm * BM + wr * 64 + fr, colt = u.pn * BM + wc * 32 + 8 * fq;
#pragma unroll
        for (int ai = 0; ai < 2; ++ai)
#pragma unroll
            for (int m = 0; m < 4; ++m)
#pragma unroll
                for (int bj = 0; bj < 2; ++bj) {
                    const size_t idx = (size_t)(row0 + ai * HALF + m * 16) * 1024 + colt + bj * HALF;
                    const bf16x8 gv = *(const bf16x8*)(G + idx);
                    float r[8];
#pragma unroll
                    for (int j = 0; j < 4; ++j) { r[j] = bf2f((bf16_t)gv[j]) * acc[ai][bj][m][0][j]; r[4 + j] = bf2f((bf16_t)gv[4 + j]) * acc[ai][bj][m][1][j]; }
                    if (PASS == 1) { const bf16x8 pv = *(const bf16x8*)(MG + idx);
#pragma unroll
                        for (int j = 0; j < 8; ++j) r[j] += bf2f((bf16_t)pv[j]); }
                    u32x4 w; w.x = cvt_pk_bf16(r[0], r[1]); w.y = cvt_pk_bf16(r[2], r[3]); w.z = cvt_pk_bf16(r[4], r[5]); w.w = cvt_pk_bf16(r[6], r[7]);
                    *(u32x4*)(MG + idx) = w;
                }
    }
};
struct EpiOut {
    static constexpr bool PERM = true;
    bf16_t* X1B; const float* x; const float* mod; const float* g2; bf16_t* XB; float* rowss;
    __device__ __forceinline__ void operator()(const f32x4 (&acc)[2][2][4][2], const Unit& u, int wr, int wc, int fr, int fq) const {
        const int row0 = u.pm * BM + wr * 64 + fr, colt = u.pn * BM + wc * 32 + 8 * fq;
        const float* mb = mod + (row0 >> 12) * 6144;
#pragma unroll
        for (int ai = 0; ai < 2; ++ai)
#pragma unroll
            for (int m = 0; m < 4; ++m) {
                const int row = row0 + ai * HALF + m * 16;
                float ss = 0.f;
#pragma unroll
                for (int bj = 0; bj < 2; ++bj) {
                    const int col = colt + bj * HALF;
                    const size_t idx = (size_t)row * 1024 + col;
                    float r[8], r1[8];
#pragma unroll
                    for (int n = 0; n < 2; ++n) {
                        const f32x4 xv = *(const f32x4*)(x + idx + 4 * n), gv = *(const f32x4*)(mb + 2048 + col + 4 * n);
                        const f32x4 x1 = xv + gv * acc[ai][bj][m][n];
                        const f32x4 gg = *(const f32x4*)(g2 + col + 4 * n), sc = *(const f32x4*)(mb + 4096 + col + 4 * n);
#pragma unroll
                        for (int j = 0; j < 4; ++j) { ss += x1[j] * x1[j]; r1[4 * n + j] = x1[j]; r[4 * n + j] = x1[j] * gg[j] * (1.f + sc[j]); }
                    }
                    u32x4 w; w.x = cvt_pk_bf16(r[0], r[1]); w.y = cvt_pk_bf16(r[2], r[3]); w.z = cvt_pk_bf16(r[4], r[5]); w.w = cvt_pk_bf16(r[6], r[7]);
                    *(u32x4*)(XB + idx) = w;
                    u32x4 w1; w1.x = cvt_pk_bf16(r1[0], r1[1]); w1.y = cvt_pk_bf16(r1[2], r1[3]); w1.z = cvt_pk_bf16(r1[4], r1[5]); w1.w = cvt_pk_bf16(r1[6], r1[7]);
                    *(u32x4*)(X1B + idx) = w1;
                }
                ss = xsum32(xsum16(ss));
                if (fq == 0) atomicAdd(rowss + row, ss);
            }
    }
};
struct EpiPQ {
    static constexpr bool PERM = true;
    bf16_t* PQ; const float* rowss; const float* pbias;
    __device__ __forceinline__ void operator()(const f32x4 (&acc)[2][2][4][2], const Unit& u, int wr, int wc, int fr, int fq) const {
        const int row0 = u.pm * BM + wr * 64 + fr, colt = u.pn * BM + wc * 32 + 8 * fq;
        const float* pb = pbias + (row0 >> 12) * 2048;
#pragma unroll
        for (int ai = 0; ai < 2; ++ai)
#pragma unroll
            for (int m = 0; m < 4; ++m) {
                const int row = row0 + ai * HALF + m * 16;
                const float rstd = rsqrtf(rowss[row] * (1.f / 1024.f) + EPS);
#pragma unroll
                for (int bj = 0; bj < 2; ++bj) {
                    const int col = colt + bj * HALF;
                    const f32x4 b0 = *(const f32x4*)(pb + col), b1 = *(const f32x4*)(pb + col + 4);
                    const f32x4 v0 = acc[ai][bj][m][0] * rstd + b0, v1 = acc[ai][bj][m][1] * rstd + b1;
                    u32x4 w; w.x = cvt_pk_bf16(v0[0], v0[1]); w.y = cvt_pk_bf16(v0[2], v0[3]); w.z = cvt_pk_bf16(v1[0], v1[1]); w.w = cvt_pk_bf16(v1[2], v1[3]);
                    *(u32x4*)(PQ + (size_t)row * 2048 + col) = w;
                }
            }
    }
};
}

__device__ __forceinline__ void conv_unit(const Params& p, int u, unsigned char* sm) {
    int tid_ = threadIdx.x; asm volatile("" : "+v"(tid_)); const int tid = tid_, lane = tid & 63, wave = tid >> 6, c = tid;
    float* y_s = (float*)sm;
    const bf16_t* A = (const bf16_t*)(p.ws + OFF_A);
    bf16_t* CACT = (bf16_t*)(p.ws + OFF_CACT);
    const int b = u >> 6, s0 = (u & 63) * 64, tokbase = b * SEQ;
    float uw[94];
#pragma unroll
    for (int i = 0; i < 94; ++i) {
        const int s = s0 - 30 + i;
        const float v = bf2f(A[(size_t)(tokbase + (s < 0 ? 0 : s)) * 512 + c]);
        uw[i] = (s < 0) ? 0.f : v;
    }
    float dw[CONVW];
#pragma unroll
    for (int w = 0; w < CONVW; ++w) dw[w] = p.conv_dw[w * 512 + c];
    const float cb = p.conv_b[c];
#pragma unroll
    for (int s = 0; s < 64; ++s) {
        float y = cb;
#pragma unroll
        for (int w = 0; w < CONVW; ++w) y += dw[w] * uw[s + w];
        y_s[s * 512 + c] = y;
    }
    __syncthreads();
    float* st = (float*)(sm + 131072);
#pragma unroll
    for (int j = 0; j < 8; ++j) {
        const float4 v0 = *(const float4*)&y_s[(wave * 8 + j) * 512 + lane * 8], v1 = *(const float4*)&y_s[(wave * 8 + j) * 512 + lane * 8 + 4];
        float s1 = v0.x + v0.y + v0.z + v0.w + v1.x + v1.y + v1.z + v1.w;
        float s2 = v0.x * v0.x + v0.y * v0.y + v0.z * v0.z + v0.w * v0.w + v1.x * v1.x + v1.y * v1.y + v1.z * v1.z + v1.w * v1.w;
        s1 = wave_allsum(s1); s2 = wave_allsum(s2);
        const float mean = s1 * (1.f / 512.f), var = s2 * (1.f / 512.f) - mean * mean;
        if (lane == 0) { st[2 * (wave * 8 + j)] = mean; st[2 * (wave * 8 + j) + 1] = rsqrtf(var + EPS); }
    }
    __syncthreads();
    const float lg = p.cln_g[c], lb = p.cln_b[c];
#pragma unroll 8
    for (int s = 0; s < 64; ++s) {
        const float z = (y_s[s * 512 + c] - st[2 * s]) * st[2 * s + 1] * lg + lb;
        CACT[(size_t)(tokbase + s0 + s) * 512 + c] = f2bf(z * __builtin_amdgcn_rcpf(1.f + __expf(-z)));
    }
    __syncthreads();
}

__device__ __forceinline__ int cvt_fp4x8(float4 a, float4 b, float sc) {
    unsigned w = 0u;
    w = __builtin_amdgcn_cvt_scalef32_pk_fp4_f32(w, a.x * sc, a.y * sc, 1.0f, 0);
    w = __builtin_amdgcn_cvt_scalef32_pk_fp4_f32(w, a.z * sc, a.w * sc, 1.0f, 1);
    w = __builtin_amdgcn_cvt_scalef32_pk_fp4_f32(w, b.x * sc, b.y * sc, 1.0f, 2);
    w = __builtin_amdgcn_cvt_scalef32_pk_fp4_f32(w, b.z * sc, b.w * sc, 1.0f, 3);
    return (int)w;
}
__device__ __forceinline__ int cvt_i4x8(float4 a, float4 b, float sc) {
#define CV_Q(x) fminf(floorf(fmaf((x), sc, 8.5f)), 15.f)
    unsigned lo = 0u, hi = 0u;
    lo = __builtin_amdgcn_cvt_pk_u8_f32(CV_Q(a.x), 0, lo); lo = __builtin_amdgcn_cvt_pk_u8_f32(CV_Q(a.y), 1, lo);
    lo = __builtin_amdgcn_cvt_pk_u8_f32(CV_Q(a.z), 2, lo); lo = __builtin_amdgcn_cvt_pk_u8_f32(CV_Q(a.w), 3, lo);
    hi = __builtin_amdgcn_cvt_pk_u8_f32(CV_Q(b.x), 0, hi); hi = __builtin_amdgcn_cvt_pk_u8_f32(CV_Q(b.y), 1, hi);
    hi = __builtin_amdgcn_cvt_pk_u8_f32(CV_Q(b.z), 2, hi); hi = __builtin_amdgcn_cvt_pk_u8_f32(CV_Q(b.w), 3, hi);
#undef CV_Q
    return (int)((lo | (hi << 4)) ^ 0x88888888u);
}
__device__ __forceinline__ int cvt_fp8x4(float4 v, float sc) {
    v.x = fminf(fmaxf(v.x * sc, -224.f), 224.f); v.y = fminf(fmaxf(v.y * sc, -224.f), 224.f);
    v.z = fminf(fmaxf(v.z * sc, -224.f), 224.f); v.w = fminf(fmaxf(v.w * sc, -224.f), 224.f);
    int w = __builtin_amdgcn_cvt_pk_fp8_f32(v.x, v.y, 0, false);
    return __builtin_amdgcn_cvt_pk_fp8_f32(v.z, v.w, w, true);
}
__device__ __forceinline__ void attn_unit(const Params& p, int u, unsigned char* sm) {
    constexpr int MTN = 2, KST = 72, VST = 68;
    int tid_ = threadIdx.x; asm volatile("" : "+v"(tid_)); const int tid = tid_, lane = tid & 63, wv = tid >> 6, fr = lane & 15, fq = lane >> 4;
    const int hd = u & 7, g = (u >> 3) & 15, b = u >> 7;
    const int ci = wv >> 1, qh = wv & 1, n = 4 * g + ci, tok0 = b * SEQ + n * 64 + qh * 32;
    const bf16_t* Q = (const bf16_t*)(p.ws + OFF_Q); const bf16_t* Kb = (const bf16_t*)(p.ws + OFF_K); const bf16_t* VT = (const bf16_t*)(p.ws + OFF_VT);
    bf16_t* OATT = (bf16_t*)(p.ws + OFF_OATT);
    float* rb = (float*)sm;
    bf16_t* Kt = (bf16_t*)(sm + 1152);
    bf16_t* Vt = (bf16_t*)(sm + 1152 + 2 * 64 * KST * 2);
    if (tid < NREL) rb[tid] = p.relb[hd * NREL + tid] * 1.4426950408889634f;
    const int c_lo = (4 * g - 8 < 0) ? 0 : 4 * g - 8, c_hi = 4 * g + 3;
    const int lrow = tid >> 3, lseg = tid & 7;
    const bf16_t* kg = Kb + (size_t)(b * SEQ + lrow) * 512 + hd * 64 + lseg * 8;
    const bf16_t* vg = VT + (size_t)(b * SEQ + lrow) * 512 + hd * 64 + lseg * 8;
    bf16x8 qf[MTN][2];
#pragma unroll
    for (int mt = 0; mt < MTN; ++mt)
#pragma unroll
        for (int ks = 0; ks < 2; ++ks) qf[mt][ks] = *(const bf16x8*)(Q + (size_t)(tok0 + mt * 16 + fr) * 512 + hd * 64 + ks * 32 + fq * 8);
    __builtin_amdgcn_sched_barrier(0);
    bf16x8 kreg = *(const bf16x8*)(kg + (size_t)c_lo * 64 * 512), vreg = *(const bf16x8*)(vg + (size_t)c_lo * 64 * 512);
    bf16x8 kA = kreg, vA = vreg, kB = kreg, vB = vreg;
    if (c_lo + 1 <= c_hi) { kA = *(const bf16x8*)(kg + (size_t)(c_lo + 1) * 64 * 512); vA = *(const bf16x8*)(vg + (size_t)(c_lo + 1) * 64 * 512); }
    float m[MTN], l[MTN]; f32x4 oacc[4][MTN];
#pragma unroll
    for (int mt = 0; mt < MTN; ++mt) { m[mt] = 0.f; l[mt] = 0.f;
#pragma unroll
        for (int dt = 0; dt < 4; ++dt) oacc[dt][mt] = (f32x4){0.f, 0.f, 0.f, 0.f}; }
    *(bf16x8*)(Kt + lrow * KST + lseg * 8) = kreg;
#pragma unroll
    for (int j = 0; j < 8; ++j) Vt[(lseg * 8 + j) * VST + lrow] = (bf16_t)vreg[j];
    __syncthreads();
    const float bconst = rb[256];
    bool first = true;
    auto step = [&](const int c, bf16x8& kN, bf16x8& vN, bf16x8& kF, bf16x8& vF) __attribute__((always_inline)) {
        const int cur = (c - c_lo) & 1;
        { const int cf = (c + 2 <= c_hi) ? c + 2 : c_hi;
          kF = *(const bf16x8*)(kg + (size_t)cf * 64 * 512); vF = *(const bf16x8*)(vg + (size_t)cf * 64 * 512); }
        const int jc = c - (n - 8);
        if (jc >= 0 && jc <= 8) {
            const bf16_t* kt_ = Kt + cur * 64 * KST + fr * KST + fq * 8;
            const bf16_t* vt_ = Vt + cur * 64 * VST + fr * VST + fq * 4;
#pragma unroll
            for (int kp = 0; kp < 2; ++kp) {
                f32x4 sacc[2][MTN];
#pragma unroll
                for (int mt = 0; mt < MTN; ++mt) {
                    const float ini = (jc < 6 ? bconst : 0.f) - (first ? 0.f : m[mt]);
#pragma unroll
                    for (int kt = 0; kt < 2; ++kt) sacc[kt][mt] = (f32x4){ini, ini, ini, ini};
                }
#pragma unroll
                for (int kt = 0; kt < 2; ++kt)
#pragma unroll
                    for (int ks = 0; ks < 2; ++ks) {
                        const bf16x8 kf = *(const bf16x8*)(kt_ + (kp * 32 + kt * 16) * KST + ks * 32);
#pragma unroll
                        for (int mt = 0; mt < MTN; ++mt) sacc[kt][mt] = __builtin_amdgcn_mfma_f32_16x16x32_bf16(kf, qf[mt][ks], sacc[kt][mt], 0, 0, 0);
                    }
                if (jc >= 6) {
#pragma unroll
                    for (int kt = 0; kt < 2; ++kt)
#pragma unroll
                        for (int mt = 0; mt < MTN; ++mt)
#pragma unroll
                            for (int r = 0; r < 4; ++r) {
                                int rel = 512 + (qh * 32 + mt * 16 + fr) - (jc * 64 + kp * 32 + kt * 16 + 4 * fq + r);
                                rel = rel > 128 ? 128 : rel;
                                sacc[kt][mt][r] += rb[rel + 128];
                            }
                }
                float mxl[MTN];
                float mxa = -1e30f;
#pragma unroll
                for (int mt = 0; mt < MTN; ++mt) {
                    float mx = fmaxf(fmaxf(sacc[0][mt][0], sacc[0][mt][1]), fmaxf(sacc[0][mt][2], sacc[0][mt][3]));
                    mx = fmaxf(mx, fmaxf(fmaxf(sacc[1][mt][0], sacc[1][mt][1]), fmaxf(sacc[1][mt][2], sacc[1][mt][3])));
                    mxl[mt] = mx; mxa = fmaxf(mxa, mx);
                }
                if (first || __any(mxa > 12.f)) {
#pragma unroll
                    for (int mt = 0; mt < MTN; ++mt) {
                        float r = xmax32(xmax16(mxl[mt]));
                        if (!first) {
                            r = fmaxf(r, 0.f);
                            const float alpha = __builtin_amdgcn_exp2f(-r);
                            l[mt] *= alpha;
#pragma unroll
                            for (int dt = 0; dt < 4; ++dt) oacc[dt][mt] *= alpha;
                            m[mt] += r;
                        } else m[mt] = r;
#pragma unroll
                        for (int kt = 0; kt < 2; ++kt) sacc[kt][mt] -= r;
                    }
                    first = false;
                }
                bf16x8 pf[MTN];
#pragma unroll
                for (int mt = 0; mt < MTN; ++mt) {
                    float sum = 0.f;
#pragma unroll
                    for (int kt = 0; kt < 2; ++kt)
#pragma unroll
                        for (int r = 0; r < 4; ++r) { const float pe = __builtin_amdgcn_exp2f(sacc[kt][mt][r]); sum += pe; sacc[kt][mt][r] = pe; }
                    l[mt] += sum;
                    pg8::u32x4 w = {pg8::cvt_pk_bf16(sacc[0][mt][0], sacc[0][mt][1]), pg8::cvt_pk_bf16(sacc[0][mt][2], sacc[0][mt][3]),
                                    pg8::cvt_pk_bf16(sacc[1][mt][0], sacc[1][mt][1]), pg8::cvt_pk_bf16(sacc[1][mt][2], sacc[1][mt][3])};
                    pf[mt] = __builtin_bit_cast(bf16x8, w);
                }
#pragma unroll
                for (int dt = 0; dt < 4; ++dt) {
                    const uint2 lo = *(const uint2*)(vt_ + dt * 16 * VST + kp * 32), hi = *(const uint2*)(vt_ + dt * 16 * VST + kp * 32 + 16);
                    pg8::u32x4 w = {lo.x, lo.y, hi.x, hi.y};
                    const bf16x8 vf = __builtin_bit_cast(bf16x8, w);
#pragma unroll
                    for (int mt = 0; mt < MTN; ++mt) oacc[dt][mt] = __builtin_amdgcn_mfma_f32_16x16x32_bf16(vf, pf[mt], oacc[dt][mt], 0, 0, 0);
                }
            }
        }
        if (c < c_hi) {
            *(bf16x8*)(Kt + (cur ^ 1) * 64 * KST + lrow * KST + lseg * 8) = kN;
#pragma unroll
            for (int j = 0; j < 8; ++j) Vt[(cur ^ 1) * 64 * VST + (lseg * 8 + j) * VST + lrow] = (bf16_t)vN[j];
        }
        __syncthreads();
    };
    for (int c = c_lo; c <= c_hi; c += 2) {
        step(c, kA, vA, kB, vB);
        step(c + 1, kB, vB, kA, vA);
    }
#pragma unroll
    for (int mt = 0; mt < MTN; ++mt) {
        const float inv = 1.f / xsum32(xsum16(l[mt]));
#pragma unroll
        for (int dt = 0; dt < 4; ++dt) {
            uint2 o; o.x = pg8::cvt_pk_bf16(oacc[dt][mt][0] * inv, oacc[dt][mt][1] * inv); o.y = pg8::cvt_pk_bf16(oacc[dt][mt][2] * inv, oacc[dt][mt][3] * inv);
            *(uint2*)(OATT + (size_t)(tok0 + mt * 16 + fr) * 512 + hd * 64 + dt * 16 + 4 * fq) = o;
        }
    }
}

__device__ __forceinline__ void st_mixers(const Params& p, unsigned char* sm) {
    constexpr int NU_CONV = 256, NU_ATT = 512;
    for (int u = blockIdx.x; u < NU_CONV + NU_ATT; u += gridDim.x) {
        if (u < NU_ATT) attn_unit(p, u, sm); else conv_unit(p, u - NU_ATT, sm);
    }
}

__device__ const unsigned char topk_cand[64] = {0, 1, 16, 2, 17, 32, 3, 18, 33, 48, 4, 19, 34, 49, 64, 5, 20, 35, 50, 65, 80, 6, 21, 36, 51, 66, 81, 96, 7, 22, 97, 112, 8, 23, 113, 128, 9, 144, 10, 160, 11, 176, 12, 192, 13, 208, 14, 224, 15, 240, 255, 255, 255, 255, 255, 255, 255, 255, 255, 255, 255, 255, 255, 255};
__device__ __forceinline__ void st_topk(const Params& p, unsigned char* sm) {
    int tid_ = threadIdx.x; asm volatile("" : "+v"(tid_)); const int tid = tid_, lane = tid & 63, wave = tid >> 6, fr = lane & 15, fq = lane >> 4;
    const bf16_t* PQ = (const bf16_t*)(p.ws + OFF_PQ); const bf16_t* KEYB = (const bf16_t*)(p.ws + OFF_KEYB);
    int* EIDX = (int*)(p.ws + OFF_EIDX); float* GATE = (float*)(p.ws + OFF_GATE);
    float* svl = (float*)sm;
    const int hl = wave >> 1, pp = wave & 1;
    int cur_hg = -1;
    bf16x8 bk[8][4];
    const int nun = (T / 16) * 2;
    unsigned* scand = (unsigned*)(sm + 8192);
    if (tid < 64) scand[tid] = topk_cand[tid];
    __syncthreads();
    bf16x8 an[4];
    if ((int)blockIdx.x < nun) {
        const int tt0 = blockIdx.x >> 1, h0 = (blockIdx.x & 1) * 4 + hl;
#pragma unroll
        for (int ks = 0; ks < 4; ++ks) an[ks] = *(const bf16x8*)(PQ + (size_t)(tt0 * 16 + fr) * 2048 + h0 * 256 + pp * 128 + fq * 8 + ks * 32);
    }
    for (int u = blockIdx.x; u < nun; u += gridDim.x) {
        const int tt = u >> 1, hg = u & 1, h = hg * 4 + hl;
        if (hg != cur_hg) {
            cur_hg = hg;
            const bf16_t* bp = KEYB + (size_t)((h * 2 + pp) * 128 + fr) * 128 + fq * 8;
#pragma unroll
            for (int kt = 0; kt < 8; ++kt)
#pragma unroll
                for (int ks = 0; ks < 4; ++ks) bk[kt][ks] = *(const bf16x8*)(bp + (size_t)kt * 16 * 128 + ks * 32);
        }
        const float4* sj_srcb = (const float4*)(u < 1024 ? p.pu : p.pv) + (size_t)(u & 1023) * 4096;
        int* sj_dstb = (int*)(p.ws + (u < 1024 ? OFF_UB : OFF_VB)) + (size_t)(u & 1023) * 2048;
        bf16x8 a[4];
#pragma unroll
        for (int ks = 0; ks < 4; ++ks) a[ks] = an[ks];
        __builtin_amdgcn_sched_barrier(0);
        float4 sj[4];
#pragma unroll
        for (int q = 0; q < 4; ++q) sj[q] = sj_srcb[2 * ((q >> 1) * 512 + tid) + (q & 1)];
        if (u + (int)gridDim.x < nun) {
            const int un = u + gridDim.x, ttn = un >> 1, hn = (un & 1) * 4 + hl;
#pragma unroll
            for (int ks = 0; ks < 4; ++ks) an[ks] = *(const bf16x8*)(PQ + (size_t)(ttn * 16 + fr) * 2048 + hn * 256 + pp * 128 + fq * 8 + ks * 32);
        }
        __builtin_amdgcn_sched_barrier(0);
        f32x4 acc[8];
#pragma unroll
        for (int kt = 0; kt < 8; ++kt) acc[kt] = (f32x4){0.f, 0.f, 0.f, 0.f};
#pragma unroll
        for (int ks = 0; ks < 4; ++ks)
#pragma unroll
            for (int kt = 0; kt < 8; ++kt) acc[kt] = __builtin_amdgcn_mfma_f32_16x16x32_bf16(a[ks], bk[kt][ks], acc[kt], 0, 0, 0);
#pragma unroll
        for (int r = 0; r < 4; ++r) {
            float s0 = packkey(acc[0][r], 0 * 16 + fr, 127u), s1 = packkey(acc[1][r], 1 * 16 + fr, 127u), s2 = packkey(acc[2][r], 2 * 16 + fr, 127u), s3 = packkey(acc[3][r], 3 * 16 + fr, 127u);
            float s4 = packkey(acc[4][r], 4 * 16 + fr, 127u), s5 = packkey(acc[5][r], 5 * 16 + fr, 127u), s6 = packkey(acc[6][r], 6 * 16 + fr, 127u), s7 = packkey(acc[7][r], 7 * 16 + fr, 127u);
            CSWAP(s0, s1); CSWAP(s2, s3); CSWAP(s4, s5); CSWAP(s6, s7);
            CSWAP(s0, s2); CSWAP(s1, s3); CSWAP(s4, s6); CSWAP(s5, s7);
            CSWAP(s1, s2); CSWAP(s5, s6); CSWAP(s0, s4); CSWAP(s3, s7);
            CSWAP(s1, s5); CSWAP(s2, s6);
            CSWAP(s1, s4); CSWAP(s3, s6);
            CSWAP(s2, s4); CSWAP(s3, s5);
            CSWAP(s3, s4);
            float mine = NEG_BIG;
#pragma unroll
            for (int it = 0; it < 16; ++it) {
                const float w = allmax16(s0);
                mine = (fr == it) ? w : mine;
                const bool pop = (s0 == w);
                s0 = pop ? s1 : s0; s1 = pop ? s2 : s1; s2 = pop ? s3 : s2; s3 = pop ? s4 : s3;
                s4 = pop ? s5 : s4; s5 = pop ? s6 : s5; s6 = pop ? s7 : s6; s7 = pop ? NEG_BIG : s7;
            }
            svl[(((4 * fq + r) * 4 + hl) * 2 + pp) * 16 + fr] = mine;
        }
        __builtin_amdgcn_sched_barrier(0);
#pragma unroll
        for (int q = 0; q < 2; ++q) sj_dstb[q * 512 + tid] = (u < 1024) ? cvt_i4x8(sj[2 * q], sj[2 * q + 1], U_SCALE) : cvt_fp4x8(sj[2 * q], sj[2 * q + 1], V_SCALE);
#pragma unroll
        for (int q = 0; q < 4; ++q) sj[q] = sj_srcb[2 * ((2 + (q >> 1)) * 512 + tid) + (q & 1)];
        __builtin_amdgcn_sched_barrier(0);
        __syncthreads();
        float c0[2], c1[2], c2[2], c3[2], mine2[2];
#pragma unroll
        for (int pass = 0; pass < 2; ++pass) {
            const int gi = pass * 32 + (tid >> 4);
            const float* ga_ = svl + gi * 32; const float* gb_ = ga_ + 16;
            float cv[4];
#pragma unroll
            for (int sl = 0; sl < 4; ++sl) {
                const int code = sl * 16 + fr; const unsigned ij = scand[code];
                const float va = ga_[(ij >> 4) & 15], vb = gb_[ij & 15];
                cv[sl] = (ij == 255u) ? NEG_BIG : packkey(va + vb, code, 63u);
            }
            CSWAP(cv[0], cv[1]); CSWAP(cv[2], cv[3]); CSWAP(cv[0], cv[2]); CSWAP(cv[1], cv[3]); CSWAP(cv[1], cv[2]);
            c0[pass] = cv[0]; c1[pass] = cv[1]; c2[pass] = cv[2]; c3[pass] = cv[3]; mine2[pass] = NEG_BIG;
        }
#pragma unroll
        for (int it = 0; it < 16; ++it)
#pragma unroll
            for (int pass = 0; pass < 2; ++pass) {
                const float w = allmax16(c0[pass]);
                mine2[pass] = (fr == it) ? w : mine2[pass];
                const bool pop = (c0[pass] == w);
                c0[pass] = pop ? c1[pass] : c0[pass]; c1[pass] = pop ? c2[pass] : c1[pass]; c2[pass] = pop ? c3[pass] : c2[pass]; c3[pass] = pop ? NEG_BIG : c3[pass];
            }
#pragma unroll
        for (int pass = 0; pass < 2; ++pass) {
            const int gi = pass * 32 + (tid >> 4), tokl = gi >> 2, hl2 = gi & 3;
            const float* ga_ = svl + gi * 32; const float* gb_ = ga_ + 16;
            const float tv = mine2[pass];
            const unsigned ij = scand[__float_as_uint(tv) & 63u];
            const int ia = (int)(__float_as_uint(ga_[(ij >> 4) & 15]) & 127u), ib = (int)(__float_as_uint(gb_[ij & 15]) & 127u);
            const float mx = allmax16(tv);
            const float ev = __expf(tv - mx);
            const float sum = allsum16(ev);
            const int t = tt * 16 + tokl, hh = hg * 4 + hl2;
            EIDX[(size_t)t * NE + hh * 16 + fr] = ia * 128 + ib;
            GATE[(size_t)t * NE + hh * 16 + fr] = ev / sum;
        }
        __builtin_amdgcn_sched_barrier(0);
#pragma unroll
        for (int q = 0; q < 2; ++q) sj_dstb[(2 + q) * 512 + tid] = (u < 1024) ? cvt_i4x8(sj[2 * q], sj[2 * q + 1], U_SCALE) : cvt_fp4x8(sj[2 * q], sj[2 * q + 1], V_SCALE);
        __syncthreads();
    }
}

typedef _Float16 h2_t __attribute__((ext_vector_type(2)));
typedef _Float16 h8_t __attribute__((ext_vector_type(8)));
typedef float f32x2 __attribute__((ext_vector_type(2)));
typedef unsigned u32x4_t __attribute__((ext_vector_type(4)));
__device__ __forceinline__ float gelu_erf(float v) {
    const float av = fabsf(v), t = __builtin_amdgcn_rcpf(av * 0.2316418882f + 1.0f);
    float q = t * 0.5307027145f + (-0.7265760135f); q = q * t + 0.7107068705f; q = q * t + (-0.142248368f); q = q * t + 0.127414796f; q = q * t;
    const float e = __builtin_amdgcn_exp2f((v * v) * (-0.72134752044f));
    const float m = v * (q * e);
    return v < 0.f ? m : v - m;
}
constexpr int TEAM = 4;
constexpr int PER = 16 / TEAM;
typedef unsigned u32x8_t __attribute__((ext_vector_type(8)));
typedef float f32x8_t __attribute__((ext_vector_type(8)));
static_assert(TEAM <= 4, "the lane-wise list registers (lev, lwv) hold up to 4 tokens");
__device__ __forceinline__ void st_experts(const Params& p, unsigned char* sm) {
    int tid_ = threadIdx.x; asm volatile("" : "+v"(tid_)); const int tid = tid_, lane = tid & 63, wave = tid >> 6;
    const bf16_t* H2 = (const bf16_t*)(p.ws + OFF_H);
    const unsigned char* UB = p.ws + OFF_UB; const unsigned char* VB = p.ws + OFF_VB;
    const int* EIDX = (const int*)(p.ws + OFF_EIDX); const float* GATE = (const float*)(p.ws + OFF_GATE);
    const float* mod = (const float*)(p.ws + OFF_MOD); const bf16_t* X1B = (const bf16_t*)(p.ws + OFF_X1B);
    constexpr int MAXT = 8 / TEAM;
    unsigned char* wl = sm + wave * 8704;
    unsigned* se0 = (unsigned*)wl; float* sg0 = (float*)(wl + 4096); unsigned* cur = (unsigned*)(wl + 8192);
    const bool a0 = lane & 1, a1 = lane & 2, a2 = lane & 4, a3 = lane & 8;
    const int nteam_w = (T / TEAM - (int)(blockIdx.x * 8 + wave) + (int)(gridDim.x * 8) - 1) / (int)(gridDim.x * 8);
  for (int tb = 0; tb < nteam_w; tb += MAXT) {
    for (int ti = 0; ti < MAXT && tb + ti < nteam_w; ++ti) {
        const int team = (tb + ti) * (int)gridDim.x * 8 + (int)blockIdx.x * 8 + wave;
        unsigned* se = se0 + ti * TEAM * NE; float* sg = sg0 + ti * TEAM * NE;
        int xq[TEAM][4];
        float tsc_lane = 0.f;
#pragma unroll
        for (int sl = 0; sl < TEAM; ++sl) {
            const size_t t = (size_t)team * TEAM + sl;
            const bf16x8 v0 = *(const bf16x8*)(H2 + t * D + 16 * lane), v1 = *(const bf16x8*)(H2 + t * D + 16 * lane + 8);
            const float rstd = rsqrtf(((const float*)(p.ws + OFF_ROWSS))[t] * (1.f / 1024.f) + EPS);
            const float* shp = mod + (t >> 12) * 6144 + 3072 + 16 * lane;
            float sh[16];
#pragma unroll
            for (int k = 0; k < 4; ++k) { const float4 q4 = *(const float4*)(shp + 4 * k); sh[4 * k] = q4.x; sh[4 * k + 1] = q4.y; sh[4 * k + 2] = q4.z; sh[4 * k + 3] = q4.w; }
            float xf[16];
#pragma unroll
            for (int k = 0; k < 8; ++k) { xf[k] = bf2f((bf16_t)v0[k]) * rstd + sh[k]; xf[8 + k] = bf2f((bf16_t)v1[k]) * rstd + sh[8 + k]; }
            float am = 0.f;
#pragma unroll
            for (int k = 0; k < 16; ++k) am = fmaxf(am, fabsf(xf[k]));
            am = xmax32(xmax16(allmax16(am)));
            const float sx = 119.f / fmaxf(am, 1e-30f);
            tsc_lane = ((lane & 15) / PER == sl) ? 1.f / (sx * U_SCALE) : tsc_lane;
#pragma unroll
            for (int g = 0; g < 2; ++g) {
                unsigned wh = 0u, wlo = 0u;
#pragma unroll
                for (int n = 0; n < 8; ++n) {
                    const int q8 = (int)rintf(xf[8 * g + (n >> 1) + 4 * (n & 1)] * sx);
                    const int ql = ((q8 + 8) & 15) - 8, qh = (q8 - ql) >> 4;
                    wh |= (unsigned)(qh & 15) << (4 * n); wlo |= (unsigned)(ql & 15) << (4 * n);
                }
                xq[sl][g] = (int)wh; xq[sl][2 + g] = (int)wlo;
            }
            const int e0 = EIDX[t * NE + lane], e1 = EIDX[t * NE + 64 + lane];
            const float g0 = GATE[t * NE + lane], g1 = GATE[t * NE + 64 + lane];
            cur[lane] = 0u; cur[64 + lane] = 0u;
            atomicAdd(&cur[e0 >> 7], 1u); atomicAdd(&cur[e1 >> 7], 1u);
            const unsigned c0 = cur[lane], c1 = cur[64 + lane];
            unsigned s0 = c0, s1 = c1;
#pragma unroll
            for (int o = 1; o < 64; o <<= 1) { const unsigned t0 = __shfl_up(s0, o), t1 = __shfl_up(s1, o); if (lane >= o) { s0 += t0; s1 += t1; } }
            const unsigned tot0 = __shfl(s0, 63);
            cur[lane] = s0 - c0; cur[64 + lane] = tot0 + s1 - c1;
#pragma unroll
            for (int it = 0; it < 2; ++it) {
                const int ee = it ? e1 : e0; const float gg = it ? g1 : g0;
                const int bkt = ee >> 7;
                unsigned long long mm = ~0ull;
#pragma unroll
                for (int bit = 0; bit < 7; ++bit) { const bool on = (bkt >> bit) & 1; const unsigned long long bal = __ballot(on); mm &= on ? bal : ~bal; }
                const unsigned rank = __builtin_amdgcn_mbcnt_hi((unsigned)(mm >> 32), __builtin_amdgcn_mbcnt_lo((unsigned)mm, 0u));
                const unsigned cnt = (unsigned)__popcll(mm);
                const unsigned base = cur[bkt];
                if (rank == cnt - 1u) cur[bkt] = base + cnt;
                se[sl * NE + base + rank] = (unsigned)ee; sg[sl * NE + base + rank] = gg;
            }
        }
#define EXP_EID(SL, IDX) ((unsigned)__builtin_amdgcn_readlane((int)(((IDX) < 64) ? lev[2 * (SL)] : lev[2 * (SL) + 1]), (IDX) & 63))
        {
            u32x2_t ur[16];
            const int kb_ = ((lane & 15) / PER) * NE + (lane & 15) % PER;
            unsigned eb = se[kb_];
#pragma unroll
            for (int k = 0; k < 16; ++k) ur[k] = ((const u32x2_t*)(UB + (size_t)(unsigned)__builtin_amdgcn_readlane((int)eb, k) * 512))[lane];
#pragma unroll 1
            for (int b = 0; b < NE / PER; ++b) {
                eb = se[kb_ + (((b + 1) * PER) & (NE - 1))];
                int d[16];
#pragma unroll
                for (int k = 0; k < 16; ++k) {
                    const u32x2_t U_ = ur[k];
                    int dh_ = __builtin_amdgcn_sdot8((int)U_[0], xq[k / PER][0], 0, false);
                    dh_ = __builtin_amdgcn_sdot8((int)U_[1], xq[k / PER][1], dh_, false);
                    int dl_ = __builtin_amdgcn_sdot8((int)U_[0], xq[k / PER][2], dh_ << 4, false);
                    d[k] = __builtin_amdgcn_sdot8((int)U_[1], xq[k / PER][3], dl_, false);
                    ur[k] = ((const u32x2_t*)(UB + (size_t)(unsigned)__builtin_amdgcn_readlane((int)eb, k) * 512))[lane];
                }
                int r1[8], r2[4], r3[2];
#pragma unroll
                for (int i = 0; i < 8; ++i) { const int keep = a0 ? d[2 * i + 1] : d[2 * i], send = a0 ? d[2 * i] : d[2 * i + 1]; r1[i] = keep + dpp_i<0xB1>(send); }
#pragma unroll
                for (int i = 0; i < 4; ++i) { const int keep = a1 ? r1[2 * i + 1] : r1[2 * i], send = a1 ? r1[2 * i] : r1[2 * i + 1]; r2[i] = keep + dpp_i<0x4E>(send); }
#pragma unroll
                for (int i = 0; i < 2; ++i) { const int keep = a2 ? r2[2 * i + 1] : r2[2 * i], send = a2 ? r2[2 * i] : r2[2 * i + 1]; r3[i] = keep + dpp_xor4_i(send); }
                int r4i;
                { const int keep = a3 ? r3[1] : r3[0], send = a3 ? r3[0] : r3[1]; r4i = keep + dpp_i<0x128>(send); }
                const float r4 = (float)xsum32_i(xsum16_i(r4i)) * tsc_lane;
                const int k_ = lane & 15, gi = (k_ / PER) * NE + b * PER + (k_ % PER);
                const float w_ = sg[gi] * gelu_erf(r4);
                if (lane < 16) sg[gi] = w_;
            }
        }
    }
    for (int ti = 0; ti < MAXT && tb + ti < nteam_w; ++ti) {
        const int team = (tb + ti) * (int)gridDim.x * 8 + (int)blockIdx.x * 8 + wave;
        const unsigned* se = se0 + ti * TEAM * NE; const float* sg = sg0 + ti * TEAM * NE;
        {
            f32x2 acc[TEAM][8];
#pragma unroll
            for (int sl = 0; sl < TEAM; ++sl)
#pragma unroll
                for (int k = 0; k < 8; ++k) acc[sl][k] = (f32x2){0.f, 0.f};
            u32x2_t vr[16];
            const int kb_ = ((lane & 15) / PER) * NE + (lane & 15) % PER;
            unsigned eb = se[kb_];
#pragma unroll
            for (int k = 0; k < 16; ++k) vr[k] = ((const u32x2_t*)(VB + (size_t)(unsigned)__builtin_amdgcn_readlane((int)eb, k) * 512))[lane];
#pragma unroll 1
            for (int b = 0; b < NE / PER; ++b) {
                const float wb = sg[kb_ + b * PER];
                eb = se[kb_ + (((b + 1) * PER) & (NE - 1))];
#pragma unroll
                for (int k = 0; k < 16; ++k) {
                    const float w_ = __int_as_float(__builtin_amdgcn_readlane(__float_as_int(wb), k));
                    const f32x2 w2 = (f32x2){w_, w_};
                    const u32x2_t V_ = vr[k];
#define EXP_VQ(q_) acc[k / PER][q_] += w2 * __builtin_amdgcn_cvt_scalef32_pk_f32_fp4(V_[0], 1.0f, q_); \
                   acc[k / PER][4 + q_] += w2 * __builtin_amdgcn_cvt_scalef32_pk_f32_fp4(V_[1], 1.0f, q_);
                    EXP_VQ(0) EXP_VQ(1) EXP_VQ(2) EXP_VQ(3)
#undef EXP_VQ
                    vr[k] = ((const u32x2_t*)(VB + (size_t)(unsigned)__builtin_amdgcn_readlane((int)eb, k) * 512))[lane];
                }
            }
#pragma unroll
            for (int sl = 0; sl < TEAM; ++sl) {
                const size_t t = (size_t)team * TEAM + sl;
                const size_t base = t * D + 16 * lane;
                const float* ga2 = mod + (t >> 12) * 6144 + 5120 + 16 * lane;
                const bf16x8 xa = *(const bf16x8*)(X1B + base), xb8 = *(const bf16x8*)(X1B + base + 8);
#pragma unroll
                for (int j4 = 0; j4 < 4; ++j4) {
                    float4 xv;
                    if (j4 < 2) { xv.x = bf2f((bf16_t)xa[4 * j4]); xv.y = bf2f((bf16_t)xa[4 * j4 + 1]); xv.z = bf2f((bf16_t)xa[4 * j4 + 2]); xv.w = bf2f((bf16_t)xa[4 * j4 + 3]); }
                    else { xv.x = bf2f((bf16_t)xb8[4 * j4 - 8]); xv.y = bf2f((bf16_t)xb8[4 * j4 - 7]); xv.z = bf2f((bf16_t)xb8[4 * j4 - 6]); xv.w = bf2f((bf16_t)xb8[4 * j4 - 5]); }
                    const float4 gv = *(const float4*)(ga2 + 4 * j4);
                    xv.x += gv.x * acc[sl][2 * j4][0] * (1.f / V_SCALE); xv.y += gv.y * acc[sl][2 * j4][1] * (1.f / V_SCALE);
                    xv.z += gv.z * acc[sl][2 * j4 + 1][0] * (1.f / V_SCALE); xv.w += gv.w * acc[sl][2 * j4 + 1][1] * (1.f / V_SCALE);
                    *(float4*)(p.out + base + 4 * j4) = xv;
                }
            }
        }
    }
  }
#undef EXP_EID
}

__device__ __forceinline__ void st_inproj8(const Params& p, unsigned char* sm) {
    pg8::Gemm g{(const bf16_t*)(p.ws + OFF_H), (const bf16_t*)(p.ws + OFF_WIN), T, DIN, D};
    pg8::StaticOrder S; S.init(T, DIN, gridDim.x, blockIdx.x);
    pg8::EpiInproj E{(bf16_t*)(p.ws + OFF_A), (bf16_t*)(p.ws + OFF_Q), (bf16_t*)(p.ws + OFF_K), (bf16_t*)(p.ws + OFF_VT), (bf16_t*)p.out, p.qng, p.kng};
    pg8::gemm_phase(( PG8_LAS unsigned char*)sm, g, S, E);
    const int nfree = (int)gridDim.x - (int)((T / 256) * (DIN / 256) % gridDim.x);
    st_prologue2(p, (float*)sm, (nfree < (int)gridDim.x) ? (int)blockIdx.x - ((int)gridDim.x - nfree) : (int)blockIdx.x, nfree);
}
__device__ __forceinline__ void st_merge8(const Params& p, unsigned char* sm) {
    st_pbias(p);
    pg8::StaticOrder S; S.init(T, D, gridDim.x, blockIdx.x);
    { pg8::Gemm g{(const bf16_t*)(p.ws + OFF_CACT), (const bf16_t*)(p.ws + OFF_WCO), T, D, 512};
      pg8::EpiMerge<0> E{(bf16_t*)(p.ws + OFF_MERGED), (const bf16_t*)p.out};
      pg8::gemm_phase((PG8_LAS unsigned char*)sm, g, S, E); }
    { pg8::Gemm g{(const bf16_t*)(p.ws + OFF_OATT), (const bf16_t*)(p.ws + OFF_WAO), T, D, 512};
      pg8::EpiMerge<1> E{(bf16_t*)(p.ws + OFF_MERGED), (const bf16_t*)p.out + (size_t)T * D};
      pg8::gemm_phase((PG8_LAS unsigned char*)sm, g, S, E); }
}
__device__ __forceinline__ void st_outproj8(const Params& p, unsigned char* sm) {
    pg8::Gemm g{(const bf16_t*)(p.ws + OFF_MERGED), (const bf16_t*)(p.ws + OFF_WO), T, D, D};
    pg8::StaticOrder S; S.init(T, D, gridDim.x, blockIdx.x);
    pg8::EpiOut E{(bf16_t*)(p.ws + OFF_X1B), p.x, (const float*)(p.ws + OFF_MOD), p.n2g, (bf16_t*)(p.ws + OFF_H), (float*)(p.ws + OFF_ROWSS)};
    pg8::gemm_phase((PG8_LAS unsigned char*)sm, g, S, E);
}
__device__ __forceinline__ void st_peerq8(const Params& p, unsigned char* sm) {
    pg8::Gemm g{(const bf16_t*)(p.ws + OFF_H), (const bf16_t*)(p.ws + OFF_WQ), T, 2048, D};
    pg8::StaticOrder S; S.init(T, 2048, gridDim.x, blockIdx.x);
    pg8::EpiPQ E{(bf16_t*)(p.ws + OFF_PQ), (const float*)(p.ws + OFF_ROWSS), (const float*)(p.ws + OFF_PBIAS)};
    pg8::gemm_phase((PG8_LAS unsigned char*)sm, g, S, E);
}

__global__ void __launch_bounds__(512, 2) mega(Params p) {
    extern __shared__ __attribute__((aligned(16))) unsigned char smem[];
    if (threadIdx.x < 4) ((unsigned*)smem)[threadIdx.x] = 0u;
    __syncthreads();
    XcdBarrier bar = xcd_barrier_post((unsigned*)(p.ws + OFF_BAR), (volatile LAS unsigned*)smem);
    unsigned char* sm = smem + 16;

    st_prologue(p, (float*)sm);
    xcd_barrier(bar);
    st_rownorm(p, p.x, p.n1g, 0, 1024, (bf16_t*)(p.ws + OFF_H));
    st_prep2(p);
    xcd_barrier(bar);
    st_inproj8(p, sm);
    xcd_barrier(bar);
    st_mixers(p, sm);
    xcd_barrier(bar);
    st_merge8(p, sm);
    xcd_barrier(bar);
    st_outproj8(p, sm);
    xcd_barrier(bar);
    st_peerq8(p, sm);
    xcd_barrier(bar);
    st_topk(p, sm);
    xcd_barrier(bar);
    st_experts(p, sm);
}

extern "C" void kernel_launch(void* const* d_in, const int* in_sizes, int n_in, void* d_out, int out_size, void* d_ws, size_t ws_size, hipStream_t stream) {
    static int grid = 0;
    if (grid == 0) {
        if (n_in != 21 || out_size != T * D || ws_size < WS_NEED) { fprintf(stderr, "kernel_launch: unexpected shapes (n_in %d out %d ws %zu)\n", n_in, out_size, ws_size); grid = -1; return; }
        int dev = 0, cus = 0, per_cu = 0;
        if (hipGetDevice(&dev) != hipSuccess || hipDeviceGetAttribute(&cus, hipDeviceAttributeMultiprocessorCount, dev) != hipSuccess) { grid = -1; return; }
        if (hipFuncSetAttribute((const void*)mega, hipFuncAttributeMaxDynamicSharedMemorySize, LDS_BYTES) != hipSuccess) { fprintf(stderr, "kernel_launch: hipFuncSetAttribute failed\n"); grid = -1; return; }
        if (hipOccupancyMaxActiveBlocksPerMultiprocessor(&per_cu, (const void*)mega, 512, LDS_BYTES) != hipSuccess || per_cu < 1) fprintf(stderr, "kernel_launch: occupancy query says %d\n", per_cu);
        (void)hipGetLastError();
        grid = cus;
    }
    if (grid < 0) return;
    (void)hipMemsetAsync((unsigned char*)d_ws + OFF_BAR, 0, 16384, stream);
    Params p{};
    p.x = (const float*)d_in[0]; p.c = (const float*)d_in[1]; p.w_ada = (const float*)d_in[2]; p.b_ada = (const float*)d_in[3];
    p.n1g = (const float*)d_in[4]; p.n2g = (const float*)d_in[5]; p.w_in = (const float*)d_in[6]; p.conv_dw = (const float*)d_in[7];
    p.conv_b = (const float*)d_in[8]; p.cln_g = (const float*)d_in[9]; p.cln_b = (const float*)d_in[10]; p.w_co = (const float*)d_in[11];
    p.qng = (const float*)d_in[12]; p.kng = (const float*)d_in[13]; p.relb = (const float*)d_in[14]; p.w_ao = (const float*)d_in[15];
    p.w_o = (const float*)d_in[16]; p.w_q = (const float*)d_in[17]; p.keys = (const float*)d_in[18]; p.pu = (const float*)d_in[19]; p.pv = (const float*)d_in[20];
    p.out = (float*)d_out; p.ws = (unsigned char*)d_ws;
    hipLaunchKernelGGL(mega, dim3(grid), dim3(512), LDS_BYTES, stream, p);
}
```

```cpp
#include <hip/hip_runtime.h>
#include <cstdio>
#include <cstdint>

typedef unsigned short bf16_t;
typedef short bf16x8 __attribute__((ext_vector_type(8)));
typedef float f32x4 __attribute__((ext_vector_type(4)));
#define LAS __attribute__((address_space(3)))

constexpr int D = 1024, BATCH = 4, SEQ = 4096, T = BATCH * SEQ;
constexpr int DIN = 4608, DC = 512, DA = 512, NH = 8, HD = 64, CHUNK = 64, NCH = SEQ / CHUNK;
constexpr int CONVW = 31, NREL = 257;
constexpr int PH = 8, NK = 128, DQ = 256, DHH = 128, TOPK = 16, NE = 128;
constexpr float EPS = 1e-6f;
#define NEG_BIG (-3.0e38f)
constexpr float U_SCALE = 96.f, V_SCALE = 5.5f;

constexpr size_t MiB = 1024 * 1024;
constexpr size_t OFF_BAR = 0, OFF_MOD = 16384, OFF_KEYB = 131072;
constexpr size_t OFF_WIN = 1 * MiB, OFF_WCO = 10 * MiB, OFF_WAO = 11 * MiB, OFF_WO = 12 * MiB, OFF_WQ = 14 * MiB;
constexpr size_t OFF_UB = 18 * MiB, OFF_VB = 34 * MiB, OFF_H = 82 * MiB;
constexpr size_t OFF_A = 114 * MiB, OFF_BG = 130 * MiB, OFF_Q = 146 * MiB, OFF_K = 162 * MiB, OFF_VT = 178 * MiB;
constexpr size_t OFF_MERGED = 114 * MiB, OFF_PQ = 114 * MiB;
constexpr size_t OFF_X1B = 48 * MiB;
constexpr size_t OFF_CACT = 194 * MiB, OFF_OATT = 210 * MiB, OFF_EIDX = 194 * MiB, OFF_GATE = 202 * MiB;
constexpr size_t OFF_LISTE = 114 * MiB, OFF_LISTG = 122 * MiB;
constexpr size_t OFF_ROWSS = 655360, OFF_PBIAS = 720896;
constexpr size_t OFF_SHB = 226 * MiB;
constexpr size_t WS_NEED = 227 * MiB;
constexpr int LDS_BYTES = 16 + 131072 + 512;

struct Params {
    const float *x, *c, *w_ada, *b_ada, *n1g, *n2g, *w_in, *conv_dw, *conv_b, *cln_g, *cln_b, *w_co, *qng, *kng, *relb, *w_ao, *w_o, *w_q, *keys, *pu, *pv;
    float* out;
    unsigned char* ws;
};

__device__ __forceinline__ bf16_t f2bf(float f) { unsigned u = __float_as_uint(f); u += 0x7fffu + ((u >> 16) & 1u); return (bf16_t)(u >> 16); }
__device__ __forceinline__ float bf2f(bf16_t h) { return __uint_as_float(((unsigned)h) << 16); }
__device__ __forceinline__ float sigmoidf_(float v) { return 1.f / (1.f + __expf(-v)); }


template <int CTRL> __device__ __forceinline__ float dpp_f(float v) { return __int_as_float(__builtin_amdgcn_update_dpp(0, __float_as_int(v), CTRL, 0xF, 0xF, false)); }
__device__ __forceinline__ float allmax16(float v) {
    v = fmaxf(v, dpp_f<0x121>(v)); v = fmaxf(v, dpp_f<0x122>(v)); v = fmaxf(v, dpp_f<0x124>(v)); v = fmaxf(v, dpp_f<0x128>(v)); return v;
}
__device__ __forceinline__ float allsum16(float v) {
    v += dpp_f<0x121>(v); v += dpp_f<0x122>(v); v += dpp_f<0x124>(v); v += dpp_f<0x128>(v); return v;
}
typedef unsigned u32x2_t __attribute__((ext_vector_type(2)));
__device__ __forceinline__ float xsum16(float v) { const u32x2_t r = __builtin_amdgcn_permlane16_swap(__float_as_uint(v), __float_as_uint(v), false, false); return __uint_as_float(r[0]) + __uint_as_float(r[1]); }
__device__ __forceinline__ float xsum32(float v) { const u32x2_t r = __builtin_amdgcn_permlane32_swap(__float_as_uint(v), __float_as_uint(v), false, false); return __uint_as_float(r[0]) + __uint_as_float(r[1]); }
__device__ __forceinline__ float xmax16(float v) { const u32x2_t r = __builtin_amdgcn_permlane16_swap(__float_as_uint(v), __float_as_uint(v), false, false); return fmaxf(__uint_as_float(r[0]), __uint_as_float(r[1])); }
__device__ __forceinline__ float xmax32(float v) { const u32x2_t r = __builtin_amdgcn_permlane32_swap(__float_as_uint(v), __float_as_uint(v), false, false); return fmaxf(__uint_as_float(r[0]), __uint_as_float(r[1])); }
__device__ __forceinline__ float wave_allsum(float v) { return xsum32(xsum16(allsum16(v))); }
__device__ __forceinline__ float dpp_xor4(float v) {
    const int x = __float_as_int(v);
    int r = __builtin_amdgcn_update_dpp(0, x, 0x104, 0xF, 0x5, false);
    r = __builtin_amdgcn_update_dpp(r, x, 0x114, 0xF, 0xA, false);
    return __int_as_float(r);
}
template <int CTRL> __device__ __forceinline__ int dpp_i(int v) { return __builtin_amdgcn_update_dpp(0, v, CTRL, 0xF, 0xF, false); }
__device__ __forceinline__ int dpp_xor4_i(int x) { int r = __builtin_amdgcn_update_dpp(0, x, 0x104, 0xF, 0x5, false); return __builtin_amdgcn_update_dpp(r, x, 0x114, 0xF, 0xA, false); }
__device__ __forceinline__ int xsum16_i(int v) { const u32x2_t r = __builtin_amdgcn_permlane16_swap((unsigned)v, (unsigned)v, false, false); return (int)(r[0] + r[1]); }
__device__ __forceinline__ int xsum32_i(int v) { const u32x2_t r = __builtin_amdgcn_permlane32_swap((unsigned)v, (unsigned)v, false, false); return (int)(r[0] + r[1]); }
__device__ __forceinline__ float packkey(float v, int idx, unsigned mask) { return __uint_as_float((__float_as_uint(v) & ~mask) | (unsigned)idx); }
#define CSWAP(a, b) do { const float _hi = fmaxf(a, b), _lo = fminf(a, b); a = _hi; b = _lo; } while (0)

#define XB_TMO      128
#define XB_XCNT(j)  (256  + 64 * (j))
#define XB_XSUB(j)  (1280 + 64 * (j))
#define XB_XGEN(j)  (2304 + 64 * (j))
#define XB_TOP      3328
#define XB_TOPGEN   3392
#define XCD_BAR_WORDS 3456
#define XB_SPIN_CAP (1u << 23)
__device__ __forceinline__ unsigned xb_ld(unsigned* p)              { return __hip_atomic_load(p, __ATOMIC_RELAXED, __HIP_MEMORY_SCOPE_AGENT); }
__device__ __forceinline__ unsigned xb_add(unsigned* p, unsigned v) { return __hip_atomic_fetch_add(p, v, __ATOMIC_RELAXED, __HIP_MEMORY_SCOPE_AGENT); }
__device__ __forceinline__ unsigned xb_xcc_id() { return (unsigned)__builtin_amdgcn_s_getreg((3 << 11) | 20) & 0xFu; }
#define XB_SPIN(cond, bar) do { unsigned _sp = 0; while (cond) { __builtin_amdgcn_s_sleep(1); \
    if ((++_sp & 255u) == 0u) { if (xb_ld(&(bar)[XB_TMO])) break; if (_sp > XB_SPIN_CAP) { atomicAdd(&(bar)[XB_TMO], 1u); break; } } } } while (0)
struct XcdBarrier { unsigned* bar; unsigned x; volatile LAS unsigned* st; };
__device__ __forceinline__ XcdBarrier xcd_barrier_post(unsigned* bar, volatile LAS unsigned* st) {
    XcdBarrier b; b.bar = bar; b.x = xb_xcc_id(); b.st = st;
    if (threadIdx.x == 0) (void)xb_add(&bar[XB_XCNT(b.x)], 1u);
    return b;
}
__device__ __forceinline__ void xcd_barrier_complete(unsigned* bar, unsigned x, unsigned& nloc, unsigned& nx) {
    const unsigned G = gridDim.x * gridDim.y * gridDim.z;
    unsigned sum, cnt, mine, sp = 0u;
    for (;;) {
        sum = 0u; cnt = 0u; mine = 0u;
#pragma unroll
        for (unsigned j = 0; j < 16; ++j) { const unsigned c = xb_ld(&bar[XB_XCNT(j)]); sum += c; cnt += (c > 0u) ? 1u : 0u; mine = (j == x) ? c : mine; }
        if (sum == G) break;
        __builtin_amdgcn_s_sleep(1);
        if ((++sp & 255u) == 0u) { if (xb_ld(&bar[XB_TMO])) break; if (sp > XB_SPIN_CAP) { atomicAdd(&bar[XB_TMO], 1u); break; } }
    }
    nloc = mine > 0u ? mine : 1u; nx = cnt > 0u ? cnt : 1u;
}
__device__ __forceinline__ void xcd_barrier(const XcdBarrier& b) {
    asm volatile("s_waitcnt vmcnt(0)" ::: "memory");
    __syncthreads();
    if (threadIdx.x == 0) {
        unsigned* bar = b.bar;
        __builtin_amdgcn_s_waitcnt(0);
        unsigned nloc = b.st[0], nx = b.st[1];
        if (nloc == 0u) { xcd_barrier_complete(bar, b.x, nloc, nx); b.st[0] = nloc; b.st[1] = nx; }
        const unsigned old = xb_add(&bar[XB_XSUB(b.x)], 1u);
        const unsigned gen = old / nloc;
        if (old + 1u == (gen + 1u) * nloc) {
            __builtin_amdgcn_fence(__ATOMIC_RELEASE, "agent");
            asm volatile("s_waitcnt vmcnt(0)" ::: "memory");
            const unsigned og = xb_add(&bar[XB_TOP], 1u);
            const unsigned tg = og / nx;
            if (og + 1u == (tg + 1u) * nx) xb_add(&bar[XB_TOPGEN], 1u);
            else XB_SPIN(xb_ld(&bar[XB_TOPGEN]) == tg, bar);
            __builtin_amdgcn_fence(__ATOMIC_ACQUIRE, "agent");
            xb_add(&bar[XB_XGEN(b.x)], 1u);
            asm volatile("s_waitcnt vmcnt(0)" ::: "memory");
        } else {
            XB_SPIN(xb_ld(&bar[XB_XGEN(b.x)]) == gen, bar);
            __builtin_amdgcn_fence(__ATOMIC_ACQUIRE, "agent");
            asm volatile("s_waitcnt vmcnt(0)" ::: "memory");
        }
    }
    __syncthreads();
}

__host__ __device__ __forceinline__ int winperm(int col) {
    if (col < 1024) { const int c = col & 511, isb = col >> 9; return 256 * (c >> 7) + 128 * isb + (c & 127); }
    if (col < 2048) { const int cc = col - 1024, t = cc >> 8, hh = (cc >> 6) & 3, dd = cc & 63; return 1024 + 256 * t + 128 * (dd >> 5) + 32 * hh + (dd & 31); }
    return col;
}

__device__ __forceinline__ void st_prologue(const Params& p, float* smf) {
    int tid_ = threadIdx.x; asm volatile("" : "+v"(tid_)); const int tid = tid_;
    constexpr int NU_MOD = 192, NU_TR = 544, NU_KEYS = 32, NU_U = 0, NU_V = 0;
    constexpr int total = NU_MOD + NU_TR + NU_KEYS + NU_U + NU_V;
    float* mod = (float*)(p.ws + OFF_MOD);
    for (int u = blockIdx.x; u < total; u += gridDim.x) {
        if (u < NU_MOD) {
            float* sc = smf;
            float* red = smf + 4096;
            for (int i = tid; i < 4096; i += 512) { const float v = p.c[i]; sc[i] = v / (1.f + expf(-v)); }
            __syncthreads();
            const int cl = tid & 31, ks = tid >> 5, col = u * 32 + cl;
            float a0 = 0.f, a1 = 0.f, a2 = 0.f, a3 = 0.f;
#pragma unroll
            for (int kk = 0; kk < 64; ++kk) {
                const int k = ks * 64 + kk;
                const float w = p.w_ada[(size_t)k * 6144 + col];
                a0 += sc[k] * w; a1 += sc[1024 + k] * w; a2 += sc[2048 + k] * w; a3 += sc[3072 + k] * w;
            }
            red[(ks * 32 + cl) * 4 + 0] = a0; red[(ks * 32 + cl) * 4 + 1] = a1; red[(ks * 32 + cl) * 4 + 2] = a2; red[(ks * 32 + cl) * 4 + 3] = a3;
            __syncthreads();
            if (tid < 128) {
                const int c2 = tid & 31, b = tid >> 5;
                float s = p.b_ada[u * 32 + c2];
                for (int k2 = 0; k2 < 16; ++k2) s += red[(k2 * 32 + c2) * 4 + b];
                mod[b * 6144 + u * 32 + c2] = s;
            }
        } else if (u < NU_MOD + NU_TR) {
            int t = u - NU_MOD;
            const float* src; bf16_t* dst; int K, N;
            if (t < 288)      { src = p.w_in; dst = (bf16_t*)(p.ws + OFF_WIN); K = 1024; N = 4608; }
            else if (t < 320) { t -= 288; src = p.w_co; dst = (bf16_t*)(p.ws + OFF_WCO); K = 512; N = 1024; }
            else if (t < 352) { t -= 320; src = p.w_ao; dst = (bf16_t*)(p.ws + OFF_WAO); K = 512; N = 1024; }
            else if (t < 416) { t -= 352; src = p.w_o; dst = (bf16_t*)(p.ws + OFF_WO); K = 1024; N = 1024; }
            else              { t -= 416; src = p.w_q; dst = (bf16_t*)(p.ws + OFF_WQ); K = 1024; N = 2048; }
            const int tiles_n = N / 256, kt = t / tiles_n, nt = t % tiles_n;
            float* tl = smf;
            float4 tv[8];
#pragma unroll
            for (int i = 0; i < 8; ++i) { const int idx = tid + 512 * i, r = idx >> 6, c4 = (idx & 63) * 4; tv[i] = *(const float4*)&src[(size_t)(kt * 64 + r) * N + nt * 256 + c4]; }
#pragma unroll
            for (int i = 0; i < 8; ++i) {
                const int idx = tid + 512 * i, r = idx >> 6, c4 = (idx & 63) * 4;
                tl[(c4 + 0) * 65 + r] = tv[i].x; tl[(c4 + 1) * 65 + r] = tv[i].y; tl[(c4 + 2) * 65 + r] = tv[i].z; tl[(c4 + 3) * 65 + r] = tv[i].w;
            }
            __syncthreads();
#pragma unroll
            for (int i = 0; i < 4; ++i) {
                const int idx = tid + 512 * i, n = idx >> 3, k8 = (idx & 7) * 8;
                bf16x8 o;
#pragma unroll
                for (int j = 0; j < 8; ++j) o[j] = (short)f2bf(tl[n * 65 + k8 + j]);
                int drow = nt * 256 + n;
                if (src == p.w_in) drow = winperm(drow);
                *(bf16x8*)&dst[(size_t)drow * K + kt * 64 + k8] = o;
            }
        } else {
            int e = u - NU_MOD - NU_TR;
            const float* src; bf16_t* dst; float sc8 = 0.f;
            if (e < NU_KEYS)             { src = p.keys; dst = (bf16_t*)(p.ws + OFF_KEYB); }
            else if (e < NU_KEYS + NU_U) { e -= NU_KEYS; src = p.pu; dst = (bf16_t*)(p.ws + OFF_UB); sc8 = U_SCALE; }
            else                         { e -= NU_KEYS + NU_U; src = p.pv; dst = (bf16_t*)(p.ws + OFF_VB); sc8 = V_SCALE; }
            if (sc8 == 0.f) {
#pragma unroll
                for (int i = 0; i < 4; ++i) {
                    const size_t idx4 = (size_t)e * 2048 + i * 512 + tid;
                    const float4 v = ((const float4*)src)[idx4];
                    ushort4 o; o.x = f2bf(v.x); o.y = f2bf(v.y); o.z = f2bf(v.z); o.w = f2bf(v.w);
                    ((ushort4*)dst)[idx4] = o;
                }
            } else {
#pragma unroll
                for (int i = 0; i < 4; ++i) {
                    const size_t idx4 = (size_t)e * 2048 + i * 512 + tid;
                    float4 v = ((const float4*)src)[idx4];
                    v.x = fminf(fmaxf(v.x * sc8, -224.f), 224.f); v.y = fminf(fmaxf(v.y * sc8, -224.f), 224.f);
                    v.z = fminf(fmaxf(v.z * sc8, -224.f), 224.f); v.w = fminf(fmaxf(v.w * sc8, -224.f), 224.f);
                    int w = __builtin_amdgcn_cvt_pk_fp8_f32(v.x, v.y, 0, false);
                    w = __builtin_amdgcn_cvt_pk_fp8_f32(v.z, v.w, w, true);
                    ((int*)dst)[idx4] = w;
                }
            }
        }
        __syncthreads();
    }
}

__device__ __forceinline__ void st_rownorm(const Params& p, const float* xin, const float* g, int off_sh, int off_sc, bf16_t* hout) {
    int tid_ = threadIdx.x; asm volatile("" : "+v"(tid_)); const int tid = tid_, lane = tid & 63, wave = tid >> 6;
    const float* mod = (const float*)(p.ws + OFF_MOD);
    constexpr int RPW = 4;
    for (int u = blockIdx.x; u < T / (8 * RPW); u += gridDim.x) {
        const int t0 = (u * 8 + wave) * RPW, b = t0 >> 12;
        float4 v[RPW][4];
#pragma unroll
        for (int r = 0; r < RPW; ++r)
#pragma unroll
            for (int i = 0; i < 4; ++i) v[r][i] = ((const float4*)(xin + (size_t)(t0 + r) * D))[lane + 64 * i];
        float4 gm[4], sh[4];
#pragma unroll
        for (int i = 0; i < 4; ++i) {
            const float4 g4 = ((const float4*)g)[lane + 64 * i];
            const float4 sc = ((const float4*)(mod + b * 6144 + off_sc))[lane + 64 * i];
            sh[i] = ((const float4*)(mod + b * 6144 + off_sh))[lane + 64 * i];
            gm[i] = make_float4(g4.x * (1.f + sc.x), g4.y * (1.f + sc.y), g4.z * (1.f + sc.z), g4.w * (1.f + sc.w));
        }
#pragma unroll
        for (int r = 0; r < RPW; ++r) {
            float ss = 0.f;
#pragma unroll
            for (int i = 0; i < 4; ++i) ss += v[r][i].x * v[r][i].x + v[r][i].y * v[r][i].y + v[r][i].z * v[r][i].z + v[r][i].w * v[r][i].w;
            ss = wave_allsum(ss);
            const float rstd = rsqrtf(ss * (1.f / D) + EPS);
#pragma unroll
            for (int i = 0; i < 4; ++i) {
                ushort4 o;
                o.x = f2bf(v[r][i].x * rstd * gm[i].x + sh[i].x);
                o.y = f2bf(v[r][i].y * rstd * gm[i].y + sh[i].y);
                o.z = f2bf(v[r][i].z * rstd * gm[i].z + sh[i].z);
                o.w = f2bf(v[r][i].w * rstd * gm[i].w + sh[i].w);
                ((ushort4*)(hout + (size_t)(t0 + r) * D))[lane + 64 * i] = o;
            }
        }
    }
}

__device__ __forceinline__ void st_prep2(const Params& p) {
    const float* mod = (const float*)(p.ws + OFF_MOD);
    float* rowss = (float*)(p.ws + OFF_ROWSS); bf16_t* SHB = (bf16_t*)(p.ws + OFF_SHB);
    for (int i = blockIdx.x * 512 + threadIdx.x; i < T + 4 * D; i += gridDim.x * 512) {
        if (i < T) rowss[i] = 0.f;
        else { const int j = i - T, b = j >> 10, k = j & 1023; SHB[b * D + k] = f2bf(mod[b * 6144 + 3072 + k]); }
    }
}

namespace pg8 {
#define PG8_LAS __attribute__((address_space(3)))
typedef unsigned u32x4 __attribute__((ext_vector_type(4)));
constexpr int BM = 256, BK = 64, HALF = 128, HTB = HALF * BK * 2, STAGE_BYTES = 8 * HTB, NXCD = 8, WGM = 8;
__host__ __device__ __forceinline__ int lds_byte(int r, int c) { const int st = (r >> 4) * 2 + (c >> 5), rr = r & 15, cc = c & 31, ob = rr * 64 + cc * 2; return st * 1024 + (ob ^ (((ob >> 9) & 1) << 5)); }
__host__ __device__ __forceinline__ void stage_rc(int b, int& R, int& C) { const int st = b / 1024, sb = b % 1024, swz = sb ^ (((sb >> 9) & 1) << 5); R = (st >> 1) * 16 + swz / 64; C = (st & 1) * 32 + (swz % 64) / 2; }
__host__ __device__ __forceinline__ int perm32(int rho) { const int n = rho >> 4, i = rho & 15; return 8 * (i >> 2) + 4 * n + (i & 3); }
struct Unit { int pm, pn; };
struct Gemm { const bf16_t* A; const bf16_t* Bt; int M, N, K; };
struct StaticOrder {
    int nM, nN, nwg, G, c;
    __host__ __device__ void init(int M, int N, int G_, int c_) { nM = M / BM; nN = N / BM; nwg = nM * nN; G = G_; c = c_; }
    __host__ __device__ bool next(int i, Unit& u) const {
        const long L = (long)i * G + c; if (L >= nwg) return false;
        int wgid = (int)L; { const int q = nwg / NXCD, r = nwg % NXCD, xcd = wgid % NXCD, off = wgid / NXCD; wgid = (xcd < r ? xcd * (q + 1) : r * (q + 1) + (xcd - r) * q) + off; }
        const int nig = WGM * nN, gid = wgid / nig, fm = gid * WGM, gsz = (nM - fm) < WGM ? (nM - fm) : WGM;
        u.pm = fm + ((wgid % nig) % gsz); u.pn = (wgid % nig) / gsz; return true;
    }
    __device__ __forceinline__ void a_ready(const Unit&) const {}
    __device__ __forceinline__ void done(const Unit&) const {}
};
__device__ __forceinline__ unsigned cvt_pk_bf16(float lo, float hi) { unsigned r; asm volatile("v_cvt_pk_bf16_f32 %0, %1, %2" : "=v"(r) : "v"(lo), "v"(hi)); return r; }

template <class Epi, class Sched>
__device__ __forceinline__ void gemm_phase(PG8_LAS unsigned char* lds, const Gemm g, const Sched& S, const Epi& E) {
    int tid = threadIdx.x; asm volatile("" : "+v"(tid));
    const int wid = __builtin_amdgcn_readfirstlane(tid >> 6), lane = tid & 63, wr = wid >> 2, wc = wid & 3, fr = lane & 15, fq = lane >> 4;
    const int K = g.K, nt = K / BK;
    unsigned voffA[2], voffB[2];
#pragma unroll
    for (int i = 0; i < 2; ++i) { int R, C; stage_rc(tid * 16 + i * 8192, R, C); const int Rb = Epi::PERM ? ((R & ~31) + perm32(R & 31)) : R;
        voffA[i] = (unsigned)(R * K + C) * 2u; voffB[i] = (unsigned)(Rb * K + C) * 2u; }
    const size_t kstep = (size_t)(BK * 2);
    const size_t hstep = (size_t)HALF * K * 2;
    const size_t tstep = 2 * hstep;
    const unsigned ldsw = (unsigned)wid * 1024u;
    const int aoff = lds_byte(wr * 64 + fr, fq * 8), boff = lds_byte(wc * 32 + fr, fq * 8);
#define PG8_SA(b, h) (((b) * 2 + (h)) * HTB)
#define PG8_SB(b, h) ((4 + (b) * 2 + (h)) * HTB)
#define PG8_STAGE(bufoff, gbase, voff) do { _Pragma("unroll") for (int _i = 0; _i < 2; ++_i) \
        __builtin_amdgcn_global_load_lds((const unsigned*)((const char*)(gbase) + (voff)[_i]), (PG8_LAS unsigned*)(lds + (bufoff) + ldsw + _i * 8192), 16, 0, 0); } while (0)
#define PG8_LDA(dst, b, h) do { _Pragma("unroll") for (int m = 0; m < 4; ++m) _Pragma("unroll") for (int k = 0; k < 2; ++k) dst[m][k] = *(const PG8_LAS bf16x8*)(lds + PG8_SA(b, h) + aoff + m * 2048 + k * 1024); } while (0)
#define PG8_LDB(dst, b, h) do { _Pragma("unroll") for (int n = 0; n < 2; ++n) _Pragma("unroll") for (int k = 0; k < 2; ++k) dst[n][k] = *(const PG8_LAS bf16x8*)(lds + PG8_SB(b, h) + boff + n * 2048 + k * 1024); } while (0)
#define PG8_MMA(ai, bj, At, Bt) do { __builtin_amdgcn_s_setprio(1); _Pragma("unroll") for (int m = 0; m < 4; ++m) _Pragma("unroll") for (int n = 0; n < 2; ++n) _Pragma("unroll") for (int k = 0; k < 2; ++k) \
        acc[ai][bj][m][n] = __builtin_amdgcn_mfma_f32_16x16x32_bf16(Bt[n][k], At[m][k], acc[ai][bj][m][n], 0, 0, 0); __builtin_amdgcn_s_setprio(0); } while (0)
#define PG8_WAIT_V(n) asm volatile("s_waitcnt vmcnt(" #n ")" ::: "memory")
#define PG8_WAIT_L(n) asm volatile("s_waitcnt lgkmcnt(" #n ")" ::: "memory")
#define PG8_BAR __builtin_amdgcn_s_barrier()
#define PG8_SCHED __builtin_amdgcn_sched_barrier(0)
    Unit cur, nxt; int ui = 0;
    if (!S.next(0, cur)) return;
    f32x4 acc[2][2][4][2];
#pragma unroll
    for (int a = 0; a < 2; ++a)
#pragma unroll
        for (int b = 0; b < 2; ++b)
#pragma unroll
            for (int m = 0; m < 4; ++m)
#pragma unroll
                for (int n = 0; n < 2; ++n) acc[a][b][m][n] = (f32x4){0.f, 0.f, 0.f, 0.f};
    bf16x8 At[4][2], B0[2][2], B1[2][2];
    const char* cA = (const char*)g.A + (size_t)cur.pm * tstep; const char* cB = (const char*)g.Bt + (size_t)cur.pn * tstep;
    S.a_ready(cur);
    PG8_STAGE(PG8_SB(0, 0), cB, voffB); PG8_STAGE(PG8_SA(0, 0), cA, voffA); PG8_STAGE(PG8_SB(0, 1), cB + hstep, voffB); PG8_STAGE(PG8_SA(0, 1), cA + hstep, voffA);
    if (wr == 1) PG8_BAR;
    PG8_WAIT_V(4); PG8_BAR;
    PG8_STAGE(PG8_SB(1, 0), cB + kstep, voffB); PG8_STAGE(PG8_SA(1, 0), cA + kstep, voffA); PG8_STAGE(PG8_SB(1, 1), cB + hstep + kstep, voffB);
    PG8_WAIT_V(6); PG8_BAR;
    for (;;) {
        const bool has_next = S.next(ui + 1, nxt);
        const char* nA = has_next ? (const char*)g.A + (size_t)nxt.pm * tstep : cA; const char* nB = has_next ? (const char*)g.Bt + (size_t)nxt.pn * tstep : cB;
        for (int t = 0; t < nt; t += 2) {
            const bool last = (t == nt - 2);
            const char* a1 = cA + (size_t)(t + 1) * kstep;
            const char* a2 = last ? nA : cA + (size_t)(t + 2) * kstep; const char* b2 = last ? nB : cB + (size_t)(t + 2) * kstep;
            const char* a3 = a2 + kstep; const char* b3 = b2 + kstep;
            if (last && has_next) S.a_ready(nxt);
            PG8_LDB(B0, 0, 0); PG8_SCHED; PG8_LDA(At, 0, 0); PG8_STAGE(PG8_SA(1, 1), a1 + hstep, voffA);
            PG8_WAIT_L(8); PG8_BAR; PG8_WAIT_L(0); PG8_MMA(0, 0, At, B0); PG8_BAR; PG8_SCHED;
            PG8_LDB(B1, 0, 1); PG8_STAGE(PG8_SB(0, 0), b2, voffB);
            PG8_BAR; PG8_WAIT_L(0); PG8_MMA(0, 1, At, B1); PG8_BAR;
            PG8_LDA(At, 0, 1); PG8_STAGE(PG8_SA(0, 0), a2, voffA);
            PG8_BAR; PG8_WAIT_L(0); PG8_MMA(1, 0, At, B0); PG8_BAR; PG8_SCHED;
            PG8_STAGE(PG8_SB(0, 1), b2 + hstep, voffB);
            PG8_WAIT_V(6); PG8_BAR; PG8_MMA(1, 1, At, B1); PG8_BAR;
            PG8_LDB(B0, 1, 0); PG8_SCHED; PG8_LDA(At, 1, 0); PG8_STAGE(PG8_SA(0, 1), a2 + hstep, voffA);
            PG8_WAIT_L(8); PG8_BAR; PG8_WAIT_L(0); PG8_MMA(0, 0, At, B0); PG8_BAR; PG8_SCHED;
            PG8_LDB(B1, 1, 1); PG8_STAGE(PG8_SB(1, 0), b3, voffB);
            PG8_BAR; PG8_WAIT_L(0); PG8_MMA(0, 1, At, B1); PG8_BAR;
            PG8_LDA(At, 1, 1); PG8_STAGE(PG8_SA(1, 0), a3, voffA);
            PG8_BAR; PG8_WAIT_L(0); PG8_MMA(1, 0, At, B0); PG8_BAR; PG8_SCHED;
            PG8_STAGE(PG8_SB(1, 1), b3 + hstep, voffB);
            PG8_WAIT_V(6); PG8_BAR; PG8_MMA(1, 1, At, B1); PG8_BAR;
        }
        E(acc, cur, wr, wc, fr, fq); S.done(cur);
        if (!has_next) break;
#pragma unroll
        for (int a = 0; a < 2; ++a)
#pragma unroll
            for (int b = 0; b < 2; ++b)
#pragma unroll
                for (int m = 0; m < 4; ++m)
#pragma unroll
                    for (int n = 0; n < 2; ++n) acc[a][b][m][n] = (f32x4){0.f, 0.f, 0.f, 0.f};
        cur = nxt; cA = nA; cB = nB; ++ui;
    }
    PG8_WAIT_V(0);
    if (wr == 0) PG8_BAR;
    PG8_BAR;
#undef PG8_SA
#undef PG8_SB
#undef PG8_STAGE
#undef PG8_LDA
#undef PG8_LDB
#undef PG8_MMA
#undef PG8_WAIT_V
#undef PG8_WAIT_L
#undef PG8_BAR
#undef PG8_SCHED
}

struct EpiInproj {
    static constexpr bool PERM = true;
    bf16_t *U, *Q, *Kb, *VT, *GC; const float *qng, *kng;
    __device__ __forceinline__ void operator()(const f32x4 (&acc)[2][2][4][2], const Unit& u, int wr, int wc, int fr, int fq) const {
        const int row0 = u.pm * BM + wr * 64 + fr, colt = u.pn * BM + wc * 32 + 8 * fq, seg = u.pn;
        if (seg < 4) {
#pragma unroll
            for (int ai = 0; ai < 2; ++ai)
#pragma unroll
                for (int m = 0; m < 4; ++m) {
                    const int row = row0 + ai * HALF + m * 16;
                    float r[8];
#pragma unroll
                    for (int j = 0; j < 4; ++j) { r[j] = acc[ai][0][m][0][j] * sigmoidf_(acc[ai][1][m][0][j]); r[4 + j] = acc[ai][0][m][1][j] * sigmoidf_(acc[ai][1][m][1][j]); }
                    u32x4 w; w.x = cvt_pk_bf16(r[0], r[1]); w.y = cvt_pk_bf16(r[2], r[3]); w.z = cvt_pk_bf16(r[4], r[5]); w.w = cvt_pk_bf16(r[6], r[7]);
                    *(u32x4*)(U + (size_t)row * 512 + 128 * seg + wc * 32 + 8 * fq) = w;
                }
        } else if (seg < 8) {
            const int t = seg - 4, isk = t >> 1, head = (t & 1) * 4 + wc;
            bf16_t* base = isk ? Kb : Q;
            const float* gp = (isk ? kng : qng) + 8 * fq;
            const f32x4 g0 = *(const f32x4*)gp, g1 = *(const f32x4*)(gp + 4), g2 = *(const f32x4*)(gp + 32), g3 = *(const f32x4*)(gp + 36);
            const float qs = isk ? 1.f : 0.18033688011112042f;
#pragma unroll
            for (int ai = 0; ai < 2; ++ai)
#pragma unroll
                for (int m = 0; m < 4; ++m) {
                    const int row = row0 + ai * HALF + m * 16;
                    const f32x4 a0 = acc[ai][0][m][0], a1 = acc[ai][0][m][1], b0 = acc[ai][1][m][0], b1 = acc[ai][1][m][1];
                    float ss = 0.f;
#pragma unroll
                    for (int j = 0; j < 4; ++j) ss += a0[j] * a0[j] + a1[j] * a1[j] + b0[j] * b0[j] + b1[j] * b1[j];
                    ss = xsum32(xsum16(ss));
                    const float rstd = rsqrtf(ss * (1.f / 64.f) + EPS) * qs;
                    const f32x4 y0 = a0 * g0 * rstd, y1 = a1 * g1 * rstd, y2 = b0 * g2 * rstd, y3 = b1 * g3 * rstd;
                    u32x4 w; w.x = cvt_pk_bf16(y0[0], y0[1]); w.y = cvt_pk_bf16(y0[2], y0[3]); w.z = cvt_pk_bf16(y1[0], y1[1]); w.w = cvt_pk_bf16(y1[2], y1[3]);
                    *(u32x4*)(base + (size_t)row * 512 + head * 64 + 8 * fq) = w;
                    w.x = cvt_pk_bf16(y2[0], y2[1]); w.y = cvt_pk_bf16(y2[2], y2[3]); w.z = cvt_pk_bf16(y3[0], y3[1]); w.w = cvt_pk_bf16(y3[2], y3[3]);
                    *(u32x4*)(base + (size_t)row * 512 + head * 64 + 32 + 8 * fq) = w;
                }
        } else {
#pragma unroll
            for (int ai = 0; ai < 2; ++ai)
#pragma unroll
                for (int m = 0; m < 4; ++m) {
                    const int row = row0 + ai * HALF + m * 16;
#pragma unroll
                    for (int bj = 0; bj < 2; ++bj) {
                        const int col = colt + bj * HALF;
                        f32x4 v0 = acc[ai][bj][m][0], v1 = acc[ai][bj][m][1];
                        if (seg < 10) {
                            u32x4 w; w.x = cvt_pk_bf16(v0[0], v0[1]); w.y = cvt_pk_bf16(v0[2], v0[3]); w.z = cvt_pk_bf16(v1[0], v1[1]); w.w = cvt_pk_bf16(v1[2], v1[3]);
                            *(u32x4*)(VT + (size_t)row * 512 + (col - 2048)) = w;
                        } else {
                            bf16_t* base = GC + (seg >= 14 ? (size_t)T * D : (size_t)0);
#pragma unroll
                            for (int j = 0; j < 4; ++j) { v0[j] = sigmoidf_(v0[j]); v1[j] = sigmoidf_(v1[j]); }
                            u32x4 w; w.x = cvt_pk_bf16(v0[0], v0[1]); w.y = cvt_pk_bf16(v0[2], v0[3]); w.z = cvt_pk_bf16(v1[0], v1[1]); w.w = cvt_pk_bf16(v1[2], v1[3]);
                            *(u32x4*)(base + (size_t)row * 1024 + ((col - 2560) & 1023)) = w;
                        }
                    }
                }
        }
    }
};
template <int PASS> struct EpiMerge {
    static constexpr bool PERM = true;
    bf16_t* MG; const bf16_t* G;
    __device__ __forceinline__ void operator()(const f32x4 (&acc)[2][2][4][2], const Unit& u, int wr, int wc, int fr, int fq) const {
        const int row0 = u.pm * BM + wr * 64 + fr, colt = u.pn * BM + wc * 32 + 8 * fq;
#pragma unroll
        for (int ai = 0; ai < 2; ++ai)
#pragma unroll
            for (int m = 0; m < 4; ++m)
#pragma unroll
                for (int bj = 0; bj < 2; ++bj) {
                    const size_t idx = (size_t)(row0 + ai * HALF + m * 16) * 1024 + colt + bj * HALF;
                    const bf16x8 gv = *(const bf16x8*)(G + idx);
                    float r[8];
#pragma unroll
                    for (int j = 0; j < 4; ++j) { r[j] = bf2f((bf16_t)gv[j]) * acc[ai][bj][m][0][j]; r[4 + j] = bf2f((bf16_t)gv[4 + j]) * acc[ai][bj][m][1][j]; }
                    if (PASS == 1) { const bf16x8 pv = *(const bf16x8*)(MG + idx);
#pragma unroll
                        for (int j = 0; j < 8; ++j) r[j] += bf2f((bf16_t)pv[j]); }
                    u32x4 w; w.x = cvt_pk_bf16(r[0], r[1]); w.y = cvt_pk_bf16(r[2], r[3]); w.z = cvt_pk_bf16(r[4], r[5]); w.w = cvt_pk_bf16(r[6], r[7]);
                    *(u32x4*)(MG + idx) = w;
                }
    }
};
struct EpiOut {
    static constexpr bool PERM = true;
    bf16_t* X1B; const float* x; const float* mod; const float* g2; bf16_t* XB; float* rowss;
    __device__ __forceinline__ void operator()(const f32x4 (&acc)[2][2][4][2], const Unit& u, int wr, int wc, int fr, int fq) const {
        const int row0 = u.pm * BM + wr * 64 + fr, colt = u.pn * BM + wc * 32 + 8 * fq;
        const float* mb = mod + (row0 >> 12) * 6144;
#pragma unroll
        for (int ai = 0; ai < 2; ++ai)
#pragma unroll
            for (int m = 0; m < 4; ++m) {
                const int row = row0 + ai * HALF + m * 16;
                float ss = 0.f;
#pragma unroll
                for (int bj = 0; bj < 2; ++bj) {
                    const int col = colt + bj * HALF;
                    const size_t idx = (size_t)row * 1024 + col;
                    float r[8], r1[8];
#pragma unroll
                    for (int n = 0; n < 2; ++n) {
                        const f32x4 xv = *(const f32x4*)(x + idx + 4 * n), gv = *(const f32x4*)(mb + 2048 + col + 4 * n);
                        const f32x4 x1 = xv + gv * acc[ai][bj][m][n];
                        const f32x4 gg = *(const f32x4*)(g2 + col + 4 * n), sc = *(const f32x4*)(mb + 4096 + col + 4 * n);
#pragma unroll
                        for (int j = 0; j < 4; ++j) { ss += x1[j] * x1[j]; r1[4 * n + j] = x1[j]; r[4 * n + j] = x1[j] * gg[j] * (1.f + sc[j]); }
                    }
                    u32x4 w; w.x = cvt_pk_bf16(r[0], r[1]); w.y = cvt_pk_bf16(r[2], r[3]); w.z = cvt_pk_bf16(r[4], r[5]); w.w = cvt_pk_bf16(r[6], r[7]);
                    *(u32x4*)(XB + idx) = w;
                    u32x4 w1; w1.x = cvt_pk_bf16(r1[0], r1[1]); w1.y = cvt_pk_bf16(r1[2], r1[3]); w1.z = cvt_pk_bf16(r1[4], r1[5]); w1.w = cvt_pk_bf16(r1[6], r1[7]);
                    *(u32x4*)(X1B + idx) = w1;
                }
                ss = xsum32(xsum16(ss));
                if (fq == 0) atomicAdd(rowss + row, ss);
            }
    }
};
struct EpiPQ {
    static constexpr bool PERM = true;
    bf16_t* PQ; const float* rowss; const float* pbias;
    __device__ __forceinline__ void operator()(const f32x4 (&acc)[2][2][4][2], const Unit& u, int wr, int wc, int fr, int fq) const {
        const int row0 = u.pm * BM + wr * 64 + fr, colt = u.pn * BM + wc * 32 + 8 * fq;
        const float* pb = pbias + (row0 >> 12) * 2048;
#pragma unroll
        for (int ai = 0; ai < 2; ++ai)
#pragma unroll
            for (int m = 0; m < 4; ++m) {
                const int row = row0 + ai * HALF + m * 16;
                const float rstd = rsqrtf(rowss[row] * (1.f / 1024.f) + EPS);
#pragma unroll
                for (int bj = 0; bj < 2; ++bj) {
                    const int col = colt + bj * HALF;
                    const f32x4 b0 = *(const f32x4*)(pb + col), b1 = *(const f32x4*)(pb + col + 4);
                    const f32x4 v0 = acc[ai][bj][m][0] * rstd + b0, v1 = acc[ai][bj][m][1] * rstd + b1;
                    u32x4 w; w.x = cvt_pk_bf16(v0[0], v0[1]); w.y = cvt_pk_bf16(v0[2], v0[3]); w.z = cvt_pk_bf16(v1[0], v1[1]); w.w = cvt_pk_bf16(v1[2], v1[3]);
                    *(u32x4*)(PQ + (size_t)row * 2048 + col) = w;
                }
            }
    }
};
struct EpiBias {
    static constexpr bool PERM = false;
    float* pbias;
    __device__ __forceinline__ void operator()(const f32x4 (&acc)[2][2][4][2], const Unit& u, int wr, int wc, int fr, int fq) const {
        if (wr == 0 && fr < 4) {
#pragma unroll
            for (int bj = 0; bj < 2; ++bj)
#pragma unroll
                for (int n = 0; n < 2; ++n) *(f32x4*)(pbias + fr * 2048 + u.pn * BM + bj * HALF + wc * 32 + n * 16 + 4 * fq) = acc[0][bj][0][n];
        }
    }
};
struct OneUnitOrder {
    int has; Unit u;
    __device__ __forceinline__ bool next(int i, Unit& o) const { if (i == 0 && has) { o = u; return true; } return false; }
    __device__ __forceinline__ void a_ready(const Unit&) const {}
    __device__ __forceinline__ void done(const Unit&) const {}
};
}

__device__ __forceinline__ void conv_unit(const Params& p, int u, unsigned char* sm) {
    int tid_ = threadIdx.x; asm volatile("" : "+v"(tid_)); const int tid = tid_, lane = tid & 63, wave = tid >> 6, c = tid;
    float* y_s = (float*)sm;
    const bf16_t* A = (const bf16_t*)(p.ws + OFF_A);
    bf16_t* CACT = (bf16_t*)(p.ws + OFF_CACT);
    const int b = u >> 6, s0 = (u & 63) * 64, tokbase = b * SEQ;
    float uw[94];
#pragma unroll
    for (int i = 0; i < 94; ++i) {
        const int s = s0 - 30 + i;
        const float v = bf2f(A[(size_t)(tokbase + (s < 0 ? 0 : s)) * 512 + c]);
        uw[i] = (s < 0) ? 0.f : v;
    }
    float dw[CONVW];
#pragma unroll
    for (int w = 0; w < CONVW; ++w) dw[w] = p.conv_dw[w * 512 + c];
    const float cb = p.conv_b[c];
#pragma unroll
    for (int s = 0; s < 64; ++s) {
        float y = cb;
#pragma unroll
        for (int w = 0; w < CONVW; ++w) y += dw[w] * uw[s + w];
        y_s[s * 512 + c] = y;
    }
    __syncthreads();
    float* st = (float*)(sm + 131072);
#pragma unroll
    for (int j = 0; j < 8; ++j) {
        const float4 v0 = *(const float4*)&y_s[(wave * 8 + j) * 512 + lane * 8], v1 = *(const float4*)&y_s[(wave * 8 + j) * 512 + lane * 8 + 4];
        float s1 = v0.x + v0.y + v0.z + v0.w + v1.x + v1.y + v1.z + v1.w;
        float s2 = v0.x * v0.x + v0.y * v0.y + v0.z * v0.z + v0.w * v0.w + v1.x * v1.x + v1.y * v1.y + v1.z * v1.z + v1.w * v1.w;
        s1 = wave_allsum(s1); s2 = wave_allsum(s2);
        const float mean = s1 * (1.f / 512.f), var = s2 * (1.f / 512.f) - mean * mean;
        if (lane == 0) { st[2 * (wave * 8 + j)] = mean; st[2 * (wave * 8 + j) + 1] = rsqrtf(var + EPS); }
    }
    __syncthreads();
    const float lg = p.cln_g[c], lb = p.cln_b[c];
#pragma unroll 8
    for (int s = 0; s < 64; ++s) {
        const float z = (y_s[s * 512 + c] - st[2 * s]) * st[2 * s + 1] * lg + lb;
        CACT[(size_t)(tokbase + s0 + s) * 512 + c] = f2bf(z * __builtin_amdgcn_rcpf(1.f + __expf(-z)));
    }
    __syncthreads();
}

__device__ __forceinline__ int cvt_fp4x8(float4 a, float4 b, float sc) {
    unsigned w = 0u;
    w = __builtin_amdgcn_cvt_scalef32_pk_fp4_f32(w, a.x * sc, a.y * sc, 1.0f, 0);
    w = __builtin_amdgcn_cvt_scalef32_pk_fp4_f32(w, a.z * sc, a.w * sc, 1.0f, 1);
    w = __builtin_amdgcn_cvt_scalef32_pk_fp4_f32(w, b.x * sc, b.y * sc, 1.0f, 2);
    w = __builtin_amdgcn_cvt_scalef32_pk_fp4_f32(w, b.z * sc, b.w * sc, 1.0f, 3);
    return (int)w;
}
__device__ __forceinline__ int cvt_i4x8(float4 a, float4 b, float sc) {
#define CV_Q(x) fminf(floorf(fmaf((x), sc, 8.5f)), 15.f)
    unsigned lo = 0u, hi = 0u;
    lo = __builtin_amdgcn_cvt_pk_u8_f32(CV_Q(a.x), 0, lo); lo = __builtin_amdgcn_cvt_pk_u8_f32(CV_Q(a.y), 1, lo);
    lo = __builtin_amdgcn_cvt_pk_u8_f32(CV_Q(a.z), 2, lo); lo = __builtin_amdgcn_cvt_pk_u8_f32(CV_Q(a.w), 3, lo);
    hi = __builtin_amdgcn_cvt_pk_u8_f32(CV_Q(b.x), 0, hi); hi = __builtin_amdgcn_cvt_pk_u8_f32(CV_Q(b.y), 1, hi);
    hi = __builtin_amdgcn_cvt_pk_u8_f32(CV_Q(b.z), 2, hi); hi = __builtin_amdgcn_cvt_pk_u8_f32(CV_Q(b.w), 3, hi);
#undef CV_Q
    return (int)((lo | (hi << 4)) ^ 0x88888888u);
}
__device__ __forceinline__ int cvt_fp8x4(float4 v, float sc) {
    v.x = fminf(fmaxf(v.x * sc, -224.f), 224.f); v.y = fminf(fmaxf(v.y * sc, -224.f), 224.f);
    v.z = fminf(fmaxf(v.z * sc, -224.f), 224.f); v.w = fminf(fmaxf(v.w * sc, -224.f), 224.f);
    int w = __builtin_amdgcn_cvt_pk_fp8_f32(v.x, v.y, 0, false);
    return __builtin_amdgcn_cvt_pk_fp8_f32(v.z, v.w, w, true);
}
__device__ __forceinline__ void attn_unit(const Params& p, int u, unsigned char* sm) {
    constexpr int MTN = 2, KST = 72, VST = 68;
    int tid_ = threadIdx.x; asm volatile("" : "+v"(tid_)); const int tid = tid_, lane = tid & 63, wv = tid >> 6, fr = lane & 15, fq = lane >> 4;
    const int hd = u & 7, g = (u >> 3) & 15, b = u >> 7;
    const int ci = wv >> 1, qh = wv & 1, n = 4 * g + ci, tok0 = b * SEQ + n * 64 + qh * 32;
    const bf16_t* Q = (const bf16_t*)(p.ws + OFF_Q); const bf16_t* Kb = (const bf16_t*)(p.ws + OFF_K); const bf16_t* VT = (const bf16_t*)(p.ws + OFF_VT);
    bf16_t* OATT = (bf16_t*)(p.ws + OFF_OATT);
    float* rb = (float*)sm;
    bf16_t* Kt = (bf16_t*)(sm + 1280);
    bf16_t* Vt = (bf16_t*)(sm + 1280 + 2 * 64 * KST * 2);
    if (tid < 320) rb[tid] = p.relb[hd * NREL + (tid < NREL ? tid : NREL - 1)] * 1.4426950408889634f;
    const int c_lo = (4 * g - 8 < 0) ? 0 : 4 * g - 8, c_hi = 4 * g + 3;
    const int lrow = tid >> 3, lseg = tid & 7;
    const bf16_t* kg = Kb + (size_t)(b * SEQ + lrow) * 512 + hd * 64 + lseg * 8;
    const bf16_t* vg = VT + (size_t)(b * SEQ + lrow) * 512 + hd * 64 + lseg * 8;
    bf16x8 kreg = *(const bf16x8*)(kg + (size_t)c_lo * 64 * 512), vreg = *(const bf16x8*)(vg + (size_t)c_lo * 64 * 512);
    bf16x8 qf[MTN][2];
#pragma unroll
    for (int mt = 0; mt < MTN; ++mt)
#pragma unroll
        for (int ks = 0; ks < 2; ++ks) qf[mt][ks] = *(const bf16x8*)(Q + (size_t)(tok0 + mt * 16 + fr) * 512 + hd * 64 + ks * 32 + fq * 8);
    float m[MTN], l[MTN]; f32x4 oacc[4][MTN];
#pragma unroll
    for (int mt = 0; mt < MTN; ++mt) { m[mt] = 0.f; l[mt] = 0.f;
#pragma unroll
        for (int dt = 0; dt < 4; ++dt) oacc[dt][mt] = (f32x4){0.f, 0.f, 0.f, 0.f}; }
    *(bf16x8*)(Kt + lrow * KST + lseg * 8) = kreg;
#pragma unroll
    for (int j = 0; j < 8; ++j) Vt[(lseg * 8 + j) * VST + lrow] = (bf16_t)vreg[j];
    __syncthreads();
    const float bconst = rb[256];
    bool first = true;
    for (int c = c_lo; c <= c_hi; ++c) {
        const int cur = (c - c_lo) & 1;
        if (c < c_hi) { kreg = *(const bf16x8*)(kg + (size_t)(c + 1) * 64 * 512); vreg = *(const bf16x8*)(vg + (size_t)(c + 1) * 64 * 512); }
        const int jc = c - (n - 8);
        if (jc >= 0 && jc <= 8) {
            const bf16_t* kt_ = Kt + cur * 64 * KST + fr * KST + fq * 8;
            const bf16_t* vt_ = Vt + cur * 64 * VST + fr * VST + fq * 4;
            f32x4 sacc[2][2][MTN];
#pragma unroll
            for (int mt = 0; mt < MTN; ++mt) {
                const float ini = (jc < 6 ? bconst : 0.f) - (first ? 0.f : m[mt]);
#pragma unroll
                for (int kp = 0; kp < 2; ++kp)
#pragma unroll
                    for (int kt = 0; kt < 2; ++kt) sacc[kp][kt][mt] = (f32x4){ini, ini, ini, ini};
            }
#pragma unroll
            for (int kp = 0; kp < 2; ++kp)
#pragma unroll
                for (int kt = 0; kt < 2; ++kt)
#pragma unroll
                    for (int ks = 0; ks < 2; ++ks) {
                        const bf16x8 kf = *(const bf16x8*)(kt_ + (kp * 32 + kt * 16) * KST + ks * 32);
#pragma unroll
                        for (int mt = 0; mt < MTN; ++mt) sacc[kp][kt][mt] = __builtin_amdgcn_mfma_f32_16x16x32_bf16(kf, qf[mt][ks], sacc[kp][kt][mt], 0, 0, 0);
                    }
            if (jc >= 6) {
                const float* bp = rb + (128 + 512 + qh * 32 + fr - jc * 64 - 4 * fq - 48 - 3);
#pragma unroll
                for (int kp = 0; kp < 2; ++kp)
#pragma unroll
                    for (int kt = 0; kt < 2; ++kt)
#pragma unroll
                        for (int mt = 0; mt < MTN; ++mt)
#pragma unroll
                            for (int r = 0; r < 4; ++r) sacc[kp][kt][mt][r] += bp[48 + 3 + mt * 16 - kp * 32 - kt * 16 - r];
            }
            float mxl[MTN];
            float mxa = -1e30f;
#pragma unroll
            for (int mt = 0; mt < MTN; ++mt) {
                float mx = -1e30f;
#pragma unroll
                for (int kp = 0; kp < 2; ++kp)
#pragma unroll
                    for (int kt = 0; kt < 2; ++kt) mx = fmaxf(mx, fmaxf(fmaxf(sacc[kp][kt][mt][0], sacc[kp][kt][mt][1]), fmaxf(sacc[kp][kt][mt][2], sacc[kp][kt][mt][3])));
                mxl[mt] = mx; mxa = fmaxf(mxa, mx);
            }
            if (first || __any(mxa > 12.f)) {
#pragma unroll
                for (int mt = 0; mt < MTN; ++mt) {
                    float r = xmax32(xmax16(mxl[mt]));
                    if (!first) {
                        r = fmaxf(r, 0.f);
                        const float alpha = __builtin_amdgcn_exp2f(-r);
                        l[mt] *= alpha;
#pragma unroll
                        for (int dt = 0; dt < 4; ++dt) oacc[dt][mt] *= alpha;
                        m[mt] += r;
                    } else m[mt] = r;
#pragma unroll
                    for (int kp = 0; kp < 2; ++kp)
#pragma unroll
                        for (int kt = 0; kt < 2; ++kt) sacc[kp][kt][mt] -= r;
                }
                first = false;
            }
            bf16x8 pf[2][MTN];
#pragma unroll
            for (int mt = 0; mt < MTN; ++mt) {
                float sum = 0.f;
#pragma unroll
                for (int kp = 0; kp < 2; ++kp) {
#pragma unroll
                    for (int kt = 0; kt < 2; ++kt)
#pragma unroll
                        for (int r = 0; r < 4; ++r) { const float pe = __builtin_amdgcn_exp2f(sacc[kp][kt][mt][r]); sum += pe; sacc[kp][kt][mt][r] = pe; }
                    pg8::u32x4 w = {pg8::cvt_pk_bf16(sacc[kp][0][mt][0], sacc[kp][0][mt][1]), pg8::cvt_pk_bf16(sacc[kp][0][mt][2], sacc[kp][0][mt][3]),
                                    pg8::cvt_pk_bf16(sacc[kp][1][mt][0], sacc[kp][1][mt][1]), pg8::cvt_pk_bf16(sacc[kp][1][mt][2], sacc[kp][1][mt][3])};
                    pf[kp][mt] = __builtin_bit_cast(bf16x8, w);
                }
                l[mt] += sum;
            }
#pragma unroll
            for (int kp = 0; kp < 2; ++kp)
#pragma unroll
                for (int dt = 0; dt < 4; ++dt) {
                    const uint2 lo = *(const uint2*)(vt_ + dt * 16 * VST + kp * 32), hi = *(const uint2*)(vt_ + dt * 16 * VST + kp * 32 + 16);
                    pg8::u32x4 w = {lo.x, lo.y, hi.x, hi.y};
                    const bf16x8 vf = __builtin_bit_cast(bf16x8, w);
#pragma unroll
                    for (int mt = 0; mt < MTN; ++mt) oacc[dt][mt] = __builtin_amdgcn_mfma_f32_16x16x32_bf16(vf, pf[kp][mt], oacc[dt][mt], 0, 0, 0);
                }
        }
        if (c < c_hi) {
            *(bf16x8*)(Kt + (cur ^ 1) * 64 * KST + lrow * KST + lseg * 8) = kreg;
#pragma unroll
            for (int j = 0; j < 8; ++j) Vt[(cur ^ 1) * 64 * VST + (lseg * 8 + j) * VST + lrow] = (bf16_t)vreg[j];
        }
        __syncthreads();
    }
#pragma unroll
    for (int mt = 0; mt < MTN; ++mt) {
        const float inv = 1.f / xsum32(xsum16(l[mt]));
#pragma unroll
        for (int dt = 0; dt < 4; ++dt) {
            uint2 o; o.x = pg8::cvt_pk_bf16(oacc[dt][mt][0] * inv, oacc[dt][mt][1] * inv); o.y = pg8::cvt_pk_bf16(oacc[dt][mt][2] * inv, oacc[dt][mt][3] * inv);
            *(uint2*)(OATT + (size_t)(tok0 + mt * 16 + fr) * 512 + hd * 64 + dt * 16 + 4 * fq) = o;
        }
    }
}

__device__ __forceinline__ void st_mixers(const Params& p, unsigned char* sm) {
    constexpr int NU_CONV = 256, NU_ATT = 512;
    for (int u = blockIdx.x; u < NU_CONV + NU_ATT; u += gridDim.x) {
        if (u < NU_ATT) attn_unit(p, u, sm); else conv_unit(p, u - NU_ATT, sm);
    }
}

__device__ const unsigned char topk_cand[64] = {0, 1, 16, 2, 17, 32, 3, 18, 33, 48, 4, 19, 34, 49, 64, 5, 20, 35, 50, 65, 80, 6, 21, 36, 51, 66, 81, 96, 7, 22, 97, 112, 8, 23, 113, 128, 9, 144, 10, 160, 11, 176, 12, 192, 13, 208, 14, 224, 15, 240, 255, 255, 255, 255, 255, 255, 255, 255, 255, 255, 255, 255, 255, 255};
__device__ __forceinline__ void st_topk(const Params& p, unsigned char* sm) {
    int tid_ = threadIdx.x; asm volatile("" : "+v"(tid_)); const int tid = tid_, lane = tid & 63, wave = tid >> 6, fr = lane & 15, fq = lane >> 4;
    const bf16_t* PQ = (const bf16_t*)(p.ws + OFF_PQ); const bf16_t* KEYB = (const bf16_t*)(p.ws + OFF_KEYB);
    int* EIDX = (int*)(p.ws + OFF_EIDX); float* GATE = (float*)(p.ws + OFF_GATE);
    float* svl = (float*)sm;
    const int hl = wave >> 1, pp = wave & 1;
    int cur_hg = -1;
    bf16x8 bk[8][4];
    const int nun = (T / 16) * 2;
    unsigned* scand = (unsigned*)(sm + 8192);
    if (tid < 64) scand[tid] = topk_cand[tid];
    __syncthreads();
    bf16x8 an[4];
    if ((int)blockIdx.x < nun) {
        const int tt0 = blockIdx.x >> 1, h0 = (blockIdx.x & 1) * 4 + hl;
#pragma unroll
        for (int ks = 0; ks < 4; ++ks) an[ks] = *(const bf16x8*)(PQ + (size_t)(tt0 * 16 + fr) * 2048 + h0 * 256 + pp * 128 + fq * 8 + ks * 32);
    }
    for (int u = blockIdx.x; u < nun; u += gridDim.x) {
        const int tt = u >> 1, hg = u & 1, h = hg * 4 + hl;
        if (hg != cur_hg) {
            cur_hg = hg;
            const bf16_t* bp = KEYB + (size_t)((h * 2 + pp) * 128 + fr) * 128 + fq * 8;
#pragma unroll
            for (int kt = 0; kt < 8; ++kt)
#pragma unroll
                for (int ks = 0; ks < 4; ++ks) bk[kt][ks] = *(const bf16x8*)(bp + (size_t)kt * 16 * 128 + ks * 32);
        }
        const float4* sj_srcb = (const float4*)(u < 1024 ? p.pu : p.pv) + (size_t)(u & 1023) * 4096;
        int* sj_dstb = (int*)(p.ws + (u < 1024 ? OFF_UB : OFF_VB)) + (size_t)(u & 1023) * 2048;
        bf16x8 a[4];
#pragma unroll
        for (int ks = 0; ks < 4; ++ks) a[ks] = an[ks];
        __builtin_amdgcn_sched_barrier(0);
        float4 sj[4];
#pragma unroll
        for (int q = 0; q < 4; ++q) sj[q] = sj_srcb[2 * ((q >> 1) * 512 + tid) + (q & 1)];
        if (u + (int)gridDim.x < nun) {
            const int un = u + gridDim.x, ttn = un >> 1, hn = (un & 1) * 4 + hl;
#pragma unroll
            for (int ks = 0; ks < 4; ++ks) an[ks] = *(const bf16x8*)(PQ + (size_t)(ttn * 16 + fr) * 2048 + hn * 256 + pp * 128 + fq * 8 + ks * 32);
        }
        __builtin_amdgcn_sched_barrier(0);
        f32x4 acc[8];
#pragma unroll
        for (int kt = 0; kt < 8; ++kt) acc[kt] = (f32x4){0.f, 0.f, 0.f, 0.f};
#pragma unroll
        for (int ks = 0; ks < 4; ++ks)
#pragma unroll
            for (int kt = 0; kt < 8; ++kt) acc[kt] = __builtin_amdgcn_mfma_f32_16x16x32_bf16(a[ks], bk[kt][ks], acc[kt], 0, 0, 0);
#pragma unroll
        for (int r = 0; r < 4; ++r) {
            float s0 = packkey(acc[0][r], 0 * 16 + fr, 127u), s1 = packkey(acc[1][r], 1 * 16 + fr, 127u), s2 = packkey(acc[2][r], 2 * 16 + fr, 127u), s3 = packkey(acc[3][r], 3 * 16 + fr, 127u);
            float s4 = packkey(acc[4][r], 4 * 16 + fr, 127u), s5 = packkey(acc[5][r], 5 * 16 + fr, 127u), s6 = packkey(acc[6][r], 6 * 16 + fr, 127u), s7 = packkey(acc[7][r], 7 * 16 + fr, 127u);
            CSWAP(s0, s1); CSWAP(s2, s3); CSWAP(s4, s5); CSWAP(s6, s7);
            CSWAP(s0, s2); CSWAP(s1, s3); CSWAP(s4, s6); CSWAP(s5, s7);
            CSWAP(s1, s2); CSWAP(s5, s6); CSWAP(s0, s4); CSWAP(s3, s7);
            CSWAP(s1, s5); CSWAP(s2, s6);
            CSWAP(s1, s4); CSWAP(s3, s6);
            CSWAP(s2, s4); CSWAP(s3, s5);
            CSWAP(s3, s4);
            float mine = NEG_BIG;
#pragma unroll
            for (int it = 0; it < 16; ++it) {
                const float w = allmax16(s0);
                mine = (fr == it) ? w : mine;
                const bool pop = (s0 == w);
                s0 = pop ? s1 : s0; s1 = pop ? s2 : s1; s2 = pop ? s3 : s2; s3 = pop ? s4 : s3;
                s4 = pop ? s5 : s4; s5 = pop ? s6 : s5; s6 = pop ? s7 : s6; s7 = pop ? NEG_BIG : s7;
            }
            svl[(((4 * fq + r) * 4 + hl) * 2 + pp) * 16 + fr] = mine;
        }
        __builtin_amdgcn_sched_barrier(0);
#pragma unroll
        for (int q = 0; q < 2; ++q) sj_dstb[q * 512 + tid] = (u < 1024) ? cvt_i4x8(sj[2 * q], sj[2 * q + 1], U_SCALE) : cvt_fp4x8(sj[2 * q], sj[2 * q + 1], V_SCALE);
#pragma unroll
        for (int q = 0; q < 4; ++q) sj[q] = sj_srcb[2 * ((2 + (q >> 1)) * 512 + tid) + (q & 1)];
        __builtin_amdgcn_sched_barrier(0);
        __syncthreads();
        float c0[2], c1[2], c2[2], c3[2], mine2[2];
#pragma unroll
        for (int pass = 0; pass < 2; ++pass) {
            const int gi = pass * 32 + (tid >> 4);
            const float* ga_ = svl + gi * 32; const float* gb_ = ga_ + 16;
            float cv[4];
#pragma unroll
            for (int sl = 0; sl < 4; ++sl) {
                const int code = sl * 16 + fr; const unsigned ij = scand[code];
                const float va = ga_[(ij >> 4) & 15], vb = gb_[ij & 15];
                cv[sl] = (ij == 255u) ? NEG_BIG : packkey(va + vb, code, 63u);
            }
            CSWAP(cv[0], cv[1]); CSWAP(cv[2], cv[3]); CSWAP(cv[0], cv[2]); CSWAP(cv[1], cv[3]); CSWAP(cv[1], cv[2]);
            c0[pass] = cv[0]; c1[pass] = cv[1]; c2[pass] = cv[2]; c3[pass] = cv[3]; mine2[pass] = NEG_BIG;
        }
#pragma unroll
        for (int it = 0; it < 16; ++it)
#pragma unroll
            for (int pass = 0; pass < 2; ++pass) {
                const float w = allmax16(c0[pass]);
                mine2[pass] = (fr == it) ? w : mine2[pass];
                const bool pop = (c0[pass] == w);
                c0[pass] = pop ? c1[pass] : c0[pass]; c1[pass] = pop ? c2[pass] : c1[pass]; c2[pass] = pop ? c3[pass] : c2[pass]; c3[pass] = pop ? NEG_BIG : c3[pass];
            }
#pragma unroll
        for (int pass = 0; pass < 2; ++pass) {
            const int gi = pass * 32 + (tid >> 4), tokl = gi >> 2, hl2 = gi & 3;
            const float* ga_ = svl + gi * 32; const float* gb_ = ga_ + 16;
            const float tv = mine2[pass];
            const unsigned ij = scand[__float_as_uint(tv) & 63u];
            const int ia = (int)(__float_as_uint(ga_[(ij >> 4) & 15]) & 127u), ib = (int)(__float_as_uint(gb_[ij & 15]) & 127u);
            const float mx = allmax16(tv);
            const float ev = __expf(tv - mx);
            const float sum = allsum16(ev);
            const int t = tt * 16 + tokl, hh = hg * 4 + hl2;
            EIDX[(size_t)t * NE + hh * 16 + fr] = ia * 128 + ib;
            GATE[(size_t)t * NE + hh * 16 + fr] = ev / sum;
        }
        __builtin_amdgcn_sched_barrier(0);
#pragma unroll
        for (int q = 0; q < 2; ++q) sj_dstb[(2 + q) * 512 + tid] = (u < 1024) ? cvt_i4x8(sj[2 * q], sj[2 * q + 1], U_SCALE) : cvt_fp4x8(sj[2 * q], sj[2 * q + 1], V_SCALE);
        __syncthreads();
    }
}

typedef _Float16 h2_t __attribute__((ext_vector_type(2)));
typedef _Float16 h8_t __attribute__((ext_vector_type(8)));
typedef float f32x2 __attribute__((ext_vector_type(2)));
typedef unsigned u32x4_t __attribute__((ext_vector_type(4)));
__device__ __forceinline__ float gelu_erf(float v) {
    const float av = fabsf(v), t = __builtin_amdgcn_rcpf(av * 0.2316418882f + 1.0f);
    float q = t * 0.5307027145f + (-0.7265760135f); q = q * t + 0.7107068705f; q = q * t + (-0.142248368f); q = q * t + 0.127414796f; q = q * t;
    const float e = __builtin_amdgcn_exp2f((v * v) * (-0.72134752044f));
    const float m = v * (q * e);
    return v < 0.f ? m : v - m;
}
constexpr int TEAM = 4;
constexpr int PER = 16 / TEAM;
typedef unsigned u32x8_t __attribute__((ext_vector_type(8)));
typedef float f32x8_t __attribute__((ext_vector_type(8)));
static_assert(TEAM <= 4, "the lane-wise list registers (lev, lwv) hold up to 4 tokens");
__device__ __forceinline__ void st_experts(const Params& p, unsigned char* sm) {
    int tid_ = threadIdx.x; asm volatile("" : "+v"(tid_)); const int tid = tid_, lane = tid & 63, wave = tid >> 6;
    const bf16_t* H2 = (const bf16_t*)(p.ws + OFF_H);
    const unsigned char* UB = p.ws + OFF_UB; const unsigned char* VB = p.ws + OFF_VB;
    const int* EIDX = (const int*)(p.ws + OFF_EIDX); const float* GATE = (const float*)(p.ws + OFF_GATE);
    const float* mod = (const float*)(p.ws + OFF_MOD); const bf16_t* X1B = (const bf16_t*)(p.ws + OFF_X1B);
    constexpr int MAXT = 8 / TEAM;
    unsigned char* wl = sm + wave * 8704;
    unsigned* se0 = (unsigned*)wl; float* sg0 = (float*)(wl + 4096); unsigned* cur = (unsigned*)(wl + 8192);
    const bool a0 = lane & 1, a1 = lane & 2, a2 = lane & 4, a3 = lane & 8;
    const int nteam_w = (T / TEAM - (int)(blockIdx.x * 8 + wave) + (int)(gridDim.x * 8) - 1) / (int)(gridDim.x * 8);
  for (int tb = 0; tb < nteam_w; tb += MAXT) {
    for (int ti = 0; ti < MAXT && tb + ti < nteam_w; ++ti) {
        const int team = (tb + ti) * (int)gridDim.x * 8 + (int)blockIdx.x * 8 + wave;
        unsigned* se = se0 + ti * TEAM * NE; float* sg = sg0 + ti * TEAM * NE;
        int xq[TEAM][4];
        float tsc_lane = 0.f;
#pragma unroll
        for (int sl = 0; sl < TEAM; ++sl) {
            const size_t t = (size_t)team * TEAM + sl;
            const bf16x8 v0 = *(const bf16x8*)(H2 + t * D + 16 * lane), v1 = *(const bf16x8*)(H2 + t * D + 16 * lane + 8);
            const float rstd = rsqrtf(((const float*)(p.ws + OFF_ROWSS))[t] * (1.f / 1024.f) + EPS);
            const float* shp = mod + (t >> 12) * 6144 + 3072 + 16 * lane;
            float sh[16];
#pragma unroll
            for (int k = 0; k < 4; ++k) { const float4 q4 = *(const float4*)(shp + 4 * k); sh[4 * k] = q4.x; sh[4 * k + 1] = q4.y; sh[4 * k + 2] = q4.z; sh[4 * k + 3] = q4.w; }
            float xf[16];
#pragma unroll
            for (int k = 0; k < 8; ++k) { xf[k] = bf2f((bf16_t)v0[k]) * rstd + sh[k]; xf[8 + k] = bf2f((bf16_t)v1[k]) * rstd + sh[8 + k]; }
            float am = 0.f;
#pragma unroll
            for (int k = 0; k < 16; ++k) am = fmaxf(am, fabsf(xf[k]));
            am = xmax32(xmax16(allmax16(am)));
            const float sx = 119.f / fmaxf(am, 1e-30f);
            tsc_lane = ((lane & 15) / PER == sl) ? 1.f / (sx * U_SCALE) : tsc_lane;
#pragma unroll
            for (int g = 0; g < 2; ++g) {
                unsigned wh = 0u, wlo = 0u;
#pragma unroll
                for (int n = 0; n < 8; ++n) {
                    const int q8 = (int)rintf(xf[8 * g + (n >> 1) + 4 * (n & 1)] * sx);
                    const int ql = ((q8 + 8) & 15) - 8, qh = (q8 - ql) >> 4;
                    wh |= (unsigned)(qh & 15) << (4 * n); wlo |= (unsigned)(ql & 15) << (4 * n);
                }
                xq[sl][g] = (int)wh; xq[sl][2 + g] = (int)wlo;
            }
            const int e0 = EIDX[t * NE + lane], e1 = EIDX[t * NE + 64 + lane];
            const float g0 = GATE[t * NE + lane], g1 = GATE[t * NE + 64 + lane];
            cur[lane] = 0u; cur[64 + lane] = 0u;
            atomicAdd(&cur[e0 >> 7], 1u); atomicAdd(&cur[e1 >> 7], 1u);
            const unsigned c0 = cur[lane], c1 = cur[64 + lane];
            unsigned s0 = c0, s1 = c1;
#pragma unroll
            for (int o = 1; o < 64; o <<= 1) { const unsigned t0 = __shfl_up(s0, o), t1 = __shfl_up(s1, o); if (lane >= o) { s0 += t0; s1 += t1; } }
            const unsigned tot0 = __shfl(s0, 63);
            cur[lane] = s0 - c0; cur[64 + lane] = tot0 + s1 - c1;
#pragma unroll
            for (int it = 0; it < 2; ++it) {
                const int ee = it ? e1 : e0; const float gg = it ? g1 : g0;
                const int bkt = ee >> 7;
                unsigned long long mm = ~0ull;
#pragma unroll
                for (int bit = 0; bit < 7; ++bit) { const bool on = (bkt >> bit) & 1; const unsigned long long bal = __ballot(on); mm &= on ? bal : ~bal; }
                const unsigned rank = __builtin_amdgcn_mbcnt_hi((unsigned)(mm >> 32), __builtin_amdgcn_mbcnt_lo((unsigned)mm, 0u));
                const unsigned cnt = (unsigned)__popcll(mm);
                const unsigned base = cur[bkt];
                if (rank == cnt - 1u) cur[bkt] = base + cnt;
                se[sl * NE + base + rank] = (unsigned)ee; sg[sl * NE + base + rank] = gg;
            }
        }
#define EXP_EID(SL, IDX) ((unsigned)__builtin_amdgcn_readlane((int)(((IDX) < 64) ? lev[2 * (SL)] : lev[2 * (SL) + 1]), (IDX) & 63))
        {
            u32x2_t ur[16];
            const int kb_ = ((lane & 15) / PER) * NE + (lane & 15) % PER;
            unsigned eb = se[kb_];
#pragma unroll
            for (int k = 0; k < 16; ++k) ur[k] = ((const u32x2_t*)(UB + (size_t)(unsigned)__builtin_amdgcn_readlane((int)eb, k) * 512))[lane];
#pragma unroll 1
            for (int b = 0; b < NE / PER; ++b) {
                eb = se[kb_ + (((b + 1) * PER) & (NE - 1))];
                int d[16];
#pragma unroll
                for (int k = 0; k < 16; ++k) {
                    const u32x2_t U_ = ur[k];
                    int dh_ = __builtin_amdgcn_sdot8((int)U_[0], xq[k / PER][0], 0, false);
                    dh_ = __builtin_amdgcn_sdot8((int)U_[1], xq[k / PER][1], dh_, false);
                    int dl_ = __builtin_amdgcn_sdot8((int)U_[0], xq[k / PER][2], dh_ << 4, false);
                    d[k] = __builtin_amdgcn_sdot8((int)U_[1], xq[k / PER][3], dl_, false);
                    ur[k] = ((const u32x2_t*)(UB + (size_t)(unsigned)__builtin_amdgcn_readlane((int)eb, k) * 512))[lane];
                }
                int r1[8], r2[4], r3[2];
#pragma unroll
                for (int i = 0; i < 8; ++i) { const int keep = a0 ? d[2 * i + 1] : d[2 * i], send = a0 ? d[2 * i] : d[2 * i + 1]; r1[i] = keep + dpp_i<0xB1>(send); }
#pragma unroll
                for (int i = 0; i < 4; ++i) { const int keep = a1 ? r1[2 * i + 1] : r1[2 * i], send = a1 ? r1[2 * i] : r1[2 * i + 1]; r2[i] = keep + dpp_i<0x4E>(send); }
#pragma unroll
                for (int i = 0; i < 2; ++i) { const int keep = a2 ? r2[2 * i + 1] : r2[2 * i], send = a2 ? r2[2 * i] : r2[2 * i + 1]; r3[i] = keep + dpp_xor4_i(send); }
                int r4i;
                { const int keep = a3 ? r3[1] : r3[0], send = a3 ? r3[0] : r3[1]; r4i = keep + dpp_i<0x128>(send); }
                const float r4 = (float)xsum32_i(xsum16_i(r4i)) * tsc_lane;
                const int k_ = lane & 15, gi = (k_ / PER) * NE + b * PER + (k_ % PER);
                const float w_ = sg[gi] * gelu_erf(r4);
                if (lane < 16) sg[gi] = w_;
            }
        }
    }
    for (int ti = 0; ti < MAXT && tb + ti < nteam_w; ++ti) {
        const int team = (tb + ti) * (int)gridDim.x * 8 + (int)blockIdx.x * 8 + wave;
        const unsigned* se = se0 + ti * TEAM * NE; const float* sg = sg0 + ti * TEAM * NE;
        {
            f32x2 acc[TEAM][8];
#pragma unroll
            for (int sl = 0; sl < TEAM; ++sl)
#pragma unroll
                for (int k = 0; k < 8; ++k) acc[sl][k] = (f32x2){0.f, 0.f};
            u32x2_t vr[16];
            const int kb_ = ((lane & 15) / PER) * NE + (lane & 15) % PER;
            unsigned eb = se[kb_];
#pragma unroll
            for (int k = 0; k < 16; ++k) vr[k] = ((const u32x2_t*)(VB + (size_t)(unsigned)__builtin_amdgcn_readlane((int)eb, k) * 512))[lane];
#pragma unroll 1
            for (int b = 0; b < NE / PER; ++b) {
                const float wb = sg[kb_ + b * PER];
                eb = se[kb_ + (((b + 1) * PER) & (NE - 1))];
#pragma unroll
                for (int k = 0; k < 16; ++k) {
                    const float w_ = __int_as_float(__builtin_amdgcn_readlane(__float_as_int(wb), k));
                    const f32x2 w2 = (f32x2){w_, w_};
                    const u32x2_t V_ = vr[k];
#define EXP_VQ(q_) acc[k / PER][q_] += w2 * __builtin_amdgcn_cvt_scalef32_pk_f32_fp4(V_[0], 1.0f, q_); \
                   acc[k / PER][4 + q_] += w2 * __builtin_amdgcn_cvt_scalef32_pk_f32_fp4(V_[1], 1.0f, q_);
                    EXP_VQ(0) EXP_VQ(1) EXP_VQ(2) EXP_VQ(3)
#undef EXP_VQ
                    vr[k] = ((const u32x2_t*)(VB + (size_t)(unsigned)__builtin_amdgcn_readlane((int)eb, k) * 512))[lane];
                }
            }
#pragma unroll
            for (int sl = 0; sl < TEAM; ++sl) {
                const size_t t = (size_t)team * TEAM + sl;
                const size_t base = t * D + 16 * lane;
                const float* ga2 = mod + (t >> 12) * 6144 + 5120 + 16 * lane;
                const bf16x8 xa = *(const bf16x8*)(X1B + base), xb8 = *(const bf16x8*)(X1B + base + 8);
#pragma unroll
                for (int j4 = 0; j4 < 4; ++j4) {
                    float4 xv;
                    if (j4 < 2) { xv.x = bf2f((bf16_t)xa[4 * j4]); xv.y = bf2f((bf16_t)xa[4 * j4 + 1]); xv.z = bf2f((bf16_t)xa[4 * j4 + 2]); xv.w = bf2f((bf16_t)xa[4 * j4 + 3]); }
                    else { xv.x = bf2f((bf16_t)xb8[4 * j4 - 8]); xv.y = bf2f((bf16_t)xb8[4 * j4 - 7]); xv.z = bf2f((bf16_t)xb8[4 * j4 - 6]); xv.w = bf2f((bf16_t)xb8[4 * j4 - 5]); }
                    const float4 gv = *(const float4*)(ga2 + 4 * j4);
                    xv.x += gv.x * acc[sl][2 * j4][0] * (1.f / V_SCALE); xv.y += gv.y * acc[sl][2 * j4][1] * (1.f / V_SCALE);
                    xv.z += gv.z * acc[sl][2 * j4 + 1][0] * (1.f / V_SCALE); xv.w += gv.w * acc[sl][2 * j4 + 1][1] * (1.f / V_SCALE);
                    *(float4*)(p.out + base + 4 * j4) = xv;
                }
            }
        }
    }
  }
#undef EXP_EID
}

__device__ __forceinline__ void st_inproj8(const Params& p, unsigned char* sm) {
    pg8::Gemm g{(const bf16_t*)(p.ws + OFF_H), (const bf16_t*)(p.ws + OFF_WIN), T, DIN, D};
    pg8::StaticOrder S; S.init(T, DIN, gridDim.x, blockIdx.x);
    pg8::EpiInproj E{(bf16_t*)(p.ws + OFF_A), (bf16_t*)(p.ws + OFF_Q), (bf16_t*)(p.ws + OFF_K), (bf16_t*)(p.ws + OFF_VT), (bf16_t*)p.out, p.qng, p.kng};
    pg8::gemm_phase(( PG8_LAS unsigned char*)sm, g, S, E);
    pg8::OneUnitOrder S2; S2.has = (blockIdx.x + 8 >= gridDim.x) ? 1 : 0; S2.u.pm = 0; S2.u.pn = (int)blockIdx.x + 8 - (int)gridDim.x;
    pg8::Gemm g2{(const bf16_t*)(p.ws + OFF_SHB), (const bf16_t*)(p.ws + OFF_WQ), 256, 2048, D};
    pg8::EpiBias E2{(float*)(p.ws + OFF_PBIAS)};
    pg8::gemm_phase((PG8_LAS unsigned char*)sm, g2, S2, E2);
}
__device__ __forceinline__ void st_merge8(const Params& p, unsigned char* sm) {
    pg8::StaticOrder S; S.init(T, D, gridDim.x, blockIdx.x);
    { pg8::Gemm g{(const bf16_t*)(p.ws + OFF_CACT), (const bf16_t*)(p.ws + OFF_WCO), T, D, 512};
      pg8::EpiMerge<0> E{(bf16_t*)(p.ws + OFF_MERGED), (const bf16_t*)p.out};
      pg8::gemm_phase((PG8_LAS unsigned char*)sm, g, S, E); }
    { pg8::Gemm g{(const bf16_t*)(p.ws + OFF_OATT), (const bf16_t*)(p.ws + OFF_WAO), T, D, 512};
      pg8::EpiMerge<1> E{(bf16_t*)(p.ws + OFF_MERGED), (const bf16_t*)p.out + (size_t)T * D};
      pg8::gemm_phase((PG8_LAS unsigned char*)sm, g, S, E); }
}
__device__ __forceinline__ void st_outproj8(const Params& p, unsigned char* sm) {
    pg8::Gemm g{(const bf16_t*)(p.ws + OFF_MERGED), (const bf16_t*)(p.ws + OFF_WO), T, D, D};
    pg8::StaticOrder S; S.init(T, D, gridDim.x, blockIdx.x);
    pg8::EpiOut E{(bf16_t*)(p.ws + OFF_X1B), p.x, (const float*)(p.ws + OFF_MOD), p.n2g, (bf16_t*)(p.ws + OFF_H), (float*)(p.ws + OFF_ROWSS)};
    pg8::gemm_phase((PG8_LAS unsigned char*)sm, g, S, E);
}
__device__ __forceinline__ void st_peerq8(const Params& p, unsigned char* sm) {
    pg8::Gemm g{(const bf16_t*)(p.ws + OFF_H), (const bf16_t*)(p.ws + OFF_WQ), T, 2048, D};
    pg8::StaticOrder S; S.init(T, 2048, gridDim.x, blockIdx.x);
    pg8::EpiPQ E{(bf16_t*)(p.ws + OFF_PQ), (const float*)(p.ws + OFF_ROWSS), (const float*)(p.ws + OFF_PBIAS)};
    pg8::gemm_phase((PG8_LAS unsigned char*)sm, g, S, E);
}

__global__ void __launch_bounds__(512, 2) mega(Params p) {
    extern __shared__ __attribute__((aligned(16))) unsigned char smem[];
    if (threadIdx.x < 4) ((unsigned*)smem)[threadIdx.x] = 0u;
    __syncthreads();
    XcdBarrier bar = xcd_barrier_post((unsigned*)(p.ws + OFF_BAR), (volatile LAS unsigned*)smem);
    unsigned char* sm = smem + 16;

    st_prologue(p, (float*)sm);
    xcd_barrier(bar);
    st_rownorm(p, p.x, p.n1g, 0, 1024, (bf16_t*)(p.ws + OFF_H));
    st_prep2(p);
    xcd_barrier(bar);
    st_inproj8(p, sm);
    xcd_barrier(bar);
    st_mixers(p, sm);
    xcd_barrier(bar);
    st_merge8(p, sm);
    xcd_barrier(bar);
    st_outproj8(p, sm);
    xcd_barrier(bar);
    st_peerq8(p, sm);
    xcd_barrier(bar);
    st_topk(p, sm);
    xcd_barrier(bar);
    st_experts(p, sm);
}

extern "C" void kernel_launch(void* const* d_in, const int* in_sizes, int n_in, void* d_out, int out_size, void* d_ws, size_t ws_size, hipStream_t stream) {
    static int grid = 0;
    if (grid == 0) {
        if (n_in != 21 || out_size != T * D || ws_size < WS_NEED) { fprintf(stderr, "kernel_launch: unexpected shapes (n_in %d out %d ws %zu)\n", n_in, out_size, ws_size); grid = -1; return; }
        int dev = 0, cus = 0, per_cu = 0;
        if (hipGetDevice(&dev) != hipSuccess || hipDeviceGetAttribute(&cus, hipDeviceAttributeMultiprocessorCount, dev) != hipSuccess) { grid = -1; return; }
        if (hipFuncSetAttribute((const void*)mega, hipFuncAttributeMaxDynamicSharedMemorySize, LDS_BYTES) != hipSuccess) { fprintf(stderr, "kernel_launch: hipFuncSetAttribute failed\n"); grid = -1; return; }
        if (hipOccupancyMaxActiveBlocksPerMultiprocessor(&per_cu, (const void*)mega, 512, LDS_BYTES) != hipSuccess || per_cu < 1) fprintf(stderr, "kernel_launch: occupancy query says %d\n", per_cu);
        (void)hipGetLastError();
        grid = cus;
    }
    if (grid < 0) return;
    (void)hipMemsetAsync((unsigned char*)d_ws + OFF_BAR, 0, 16384, stream);
    Params p{};
    p.x = (const float*)d_in[0]; p.c = (const float*)d_in[1]; p.w_ada = (const float*)d_in[2]; p.b_ada = (const float*)d_in[3];
    p.n1g = (const float*)d_in[4]; p.n2g = (const float*)d_in[5]; p.w_in = (const float*)d_in[6]; p.conv_dw = (const float*)d_in[7];
    p.conv_b = (const float*)d_in[8]; p.cln_g = (const float*)d_in[9]; p.cln_b = (const float*)d_in[10]; p.w_co = (const float*)d_in[11];
    p.qng = (const float*)d_in[12]; p.kng = (const float*)d_in[13]; p.relb = (const float*)d_in[14]; p.w_ao = (const float*)d_in[15];
    p.w_o = (const float*)d_in[16]; p.w_q = (const float*)d_in[17]; p.keys = (const float*)d_in[18]; p.pu = (const float*)d_in[19]; p.pv = (const float*)d_in[20];
    p.out = (float*)d_out; p.ws = (unsigned char*)d_ws;
    hipLaunchKernelGGL(mega, dim3(grid), dim3(512), LDS_BYTES, stream, p);
}
```
